# Optimizing an MI355X kernel written in HIP

```python
import math
import jax, jax.numpy as jnp
from jax import lax
import numpy as np

D_MODEL = 4096
BATCH = 4
SEQ = 2048
DEPTH = 1

HEAD_DIM = 128
ATTN_HEADS = D_MODEL // 2 // HEAD_DIM
ATTN_KV_HEADS = 2
ATTN_GROUP = ATTN_HEADS // ATTN_KV_HEADS
WINDOW = 128
BLOCK = 128
N_BUCKETS = 32
MAX_DISTANCE = 128
GLA_HEADS = 4
GLA_DV = D_MODEL // 2 // GLA_HEADS
GLA_DK = GLA_DV // 2
GLA_RANK = 16
GLA_TAU = 16.0
GLA_CHUNK = 64
ATTN_Q = ATTN_HEADS * HEAD_DIM
ATTN_KV = ATTN_KV_HEADS * HEAD_DIM
GLA_K = GLA_HEADS * GLA_DK
GLA_V = GLA_HEADS * GLA_DV
MIX_WIDTH = ATTN_Q + GLA_V
IN_WIDTH = ATTN_Q + 2 * ATTN_KV + 2 * GLA_K + GLA_V + GLA_RANK + GLA_V
PEER_HEADS = 8
N_KEYS = 128
N_EXPERTS = N_KEYS * N_KEYS
PEER_TOPK = 16
PEER_DKEY = 256
PEER_TOKEN_BLOCK = 128
N_MOD = 6
EPS = 1e-6
NEG_INF = -1e30

kernel_name = "hybrid_swa_gla_peer_adaln"


def rmsnorm(x, g):
    xf = x.astype(jnp.float32)
    y = xf * lax.rsqrt(jnp.mean(xf * xf, axis=-1, keepdims=True) + EPS)
    return (y * g.astype(jnp.float32)).astype(x.dtype)


def t5_causal_bucket(dist):
    max_exact = N_BUCKETS // 2
    d = jnp.maximum(dist, 0)
    log_ratio = jnp.log(jnp.maximum(d, 1).astype(jnp.float32) / max_exact) / math.log(MAX_DISTANCE / max_exact)
    large = max_exact + (log_ratio * (N_BUCKETS - max_exact)).astype(jnp.int32)
    large = jnp.minimum(large, N_BUCKETS - 1)
    return jnp.where(d < max_exact, d, large)


def sliding_window_attention(q, k, v, sinks, rel_bias):
    B, T = q.shape[0], q.shape[1]
    nb = T // BLOCK
    qb = q.reshape(B, nb, BLOCK, ATTN_KV_HEADS, ATTN_GROUP, HEAD_DIM)

    def with_prev(a):
        a = a.reshape(B, nb, BLOCK, ATTN_KV_HEADS, HEAD_DIM)
        prev = jnp.pad(a, ((0, 0), (1, 0), (0, 0), (0, 0), (0, 0)))[:, :-1]
        return jnp.concatenate([prev, a], axis=2)

    kb, vb = with_prev(k), with_prev(v)
    s = jnp.einsum('bnqhgd,bnkhd->bnhgqk', qb, kb,
                   preferred_element_type=jnp.float32) * (HEAD_DIM ** -0.5)
    qi = jnp.arange(BLOCK)[:, None]
    kj = jnp.arange(2 * BLOCK)[None, :]
    dist = qi + BLOCK - kj
    in_window = (dist >= 0) & (dist < WINDOW)
    bias = rel_bias.astype(jnp.float32)[t5_causal_bucket(dist)]
    bias = bias.transpose(2, 0, 1).reshape(ATTN_KV_HEADS, ATTN_GROUP, BLOCK, 2 * BLOCK)
    kpos = jnp.arange(nb)[:, None] * BLOCK - BLOCK + jnp.arange(2 * BLOCK)[None, :]
    mask = in_window[None] & (kpos >= 0)[:, None, :]
    s = jnp.where(mask[None, :, None, None], s + bias[None, None], NEG_INF)
    sink = sinks.astype(jnp.float32).reshape(ATTN_KV_HEADS, ATTN_GROUP)[None, None, :, :, None, None]
    m = jnp.maximum(jnp.max(s, axis=-1, keepdims=True), sink)
    p = jnp.exp(s - m)
    p = p / (jnp.sum(p, axis=-1, keepdims=True) + jnp.exp(sink - m))
    o = jnp.einsum('bnhgqk,bnkhd->bnqhgd', p.astype(v.dtype), vb)
    return o.reshape(B, T, ATTN_Q)


def gated_linear_attention(q, k, v, log_a):
    B, T, H, dk = q.shape
    dv = v.shape[-1]
    nc, C = T // GLA_CHUNK, GLA_CHUNK

    def chunked(a):
        return a.astype(jnp.float32).reshape(B, nc, C, H, a.shape[-1]).transpose(0, 1, 3, 2, 4)

    q, k, v, log_a = chunked(q) * (dk ** -0.5), chunked(k), chunked(v), chunked(log_a)
    b = jnp.cumsum(log_a, axis=3)
    b_last = b[:, :, :, -1:, :]
    q_dec = q * jnp.exp(b)
    k_inv = k * jnp.exp(-b)
    k_dec = k * jnp.exp(b_last - b)
    causal = jnp.tril(jnp.ones((C, C), dtype=bool))
    attn = jnp.where(causal, jnp.einsum('bnhid,bnhjd->bnhij', q_dec, k_inv), 0.0)
    o_intra = jnp.einsum('bnhij,bnhjv->bnhiv', attn, v)

    def step(S, inp):
        qd, kd, vc, dl = inp
        o = jnp.einsum('bhcd,bhdv->bhcv', qd, S)
        S = dl[..., None] * S + jnp.einsum('bhcd,bhcv->bhdv', kd, vc)
        return S, o

    S0 = jnp.zeros((B, H, dk, dv), jnp.float32)
    xs = (q_dec.swapaxes(0, 1), k_dec.swapaxes(0, 1), v.swapaxes(0, 1),
          jnp.exp(b_last[:, :, :, 0, :]).swapaxes(0, 1))
    _, o_inter = lax.scan(step, S0, xs)
    o = o_intra + o_inter.swapaxes(0, 1)
    return o.transpose(0, 1, 3, 2, 4).reshape(B, T, H, dv)


def peer(h, w_q, sub_keys, u, v):
    B, T, D = h.shape
    tokens = h.reshape(B * T, D)
    q = (tokens @ w_q).astype(jnp.float32).reshape(B * T, PEER_HEADS, 2, PEER_DKEY // 2)
    s = jnp.einsum('nhpd,hpkd->nhpk', q, sub_keys.astype(jnp.float32))
    s1, i1 = lax.top_k(s[:, :, 0], PEER_TOPK)
    s2, i2 = lax.top_k(s[:, :, 1], PEER_TOPK)
    cand_s = (s1[..., :, None] + s2[..., None, :]).reshape(B * T, PEER_HEADS, PEER_TOPK * PEER_TOPK)
    cand_i = (i1[..., :, None] * N_KEYS + i2[..., None, :]).reshape(B * T, PEER_HEADS, PEER_TOPK * PEER_TOPK)
    top_s, pos = lax.top_k(cand_s, PEER_TOPK)
    idx = jnp.take_along_axis(cand_i, pos, axis=-1)
    gates = jax.nn.softmax(top_s, axis=-1)
    nblk = (B * T) // PEER_TOKEN_BLOCK

    def block(args):
        xt, ib, gb = args
        act = jnp.einsum('phkd,pd->phk', u[ib], xt, preferred_element_type=jnp.float32)
        w = (gb * jax.nn.gelu(act, approximate=False)).astype(xt.dtype)
        return jnp.einsum('phk,phkd->pd', w, v[ib])

    out = lax.map(block, (tokens.reshape(nblk, PEER_TOKEN_BLOCK, D),
                          idx.reshape(nblk, PEER_TOKEN_BLOCK, PEER_HEADS, PEER_TOPK),
                          gates.reshape(nblk, PEER_TOKEN_BLOCK, PEER_HEADS, PEER_TOPK)))
    return out.reshape(B, T, D)


def hybrid_layer(x, mod, norm1_g, norm2_g, w_in, sinks, rel_bias, gk2_w, gk2_b,
                 gla_norm_g, w_out, peer_w_q, peer_keys, peer_u, peer_v):
    B, T, _ = x.shape
    shift1, scale1, gate1, shift2, scale2, gate2 = jnp.split(mod[:, None, :], N_MOD, axis=-1)
    h = rmsnorm(x, norm1_g) * (1 + scale1) + shift1
    proj = h @ w_in
    widths = [ATTN_Q, ATTN_KV, ATTN_KV, GLA_K, GLA_K, GLA_V, GLA_RANK, GLA_V]
    offs = [int(o) for o in np.cumsum(widths)[:-1]]
    aq, ak, av, gq, gk, gv, glow, gout = jnp.split(proj, offs, axis=-1)
    attn_out = sliding_window_attention(
        aq.reshape(B, T, ATTN_HEADS, HEAD_DIM), ak.reshape(B, T, ATTN_KV_HEADS, HEAD_DIM),
        av.reshape(B, T, ATTN_KV_HEADS, HEAD_DIM), sinks, rel_bias)
    log_a = jax.nn.log_sigmoid((glow @ gk2_w + gk2_b).astype(jnp.float32)) / GLA_TAU
    gla_o = gated_linear_attention(
        gq.reshape(B, T, GLA_HEADS, GLA_DK), gk.reshape(B, T, GLA_HEADS, GLA_DK),
        gv.reshape(B, T, GLA_HEADS, GLA_DV), log_a.reshape(B, T, GLA_HEADS, GLA_DK))
    gla_o = rmsnorm(gla_o, gla_norm_g) * jax.nn.silu(gout.reshape(B, T, GLA_HEADS, GLA_DV).astype(jnp.float32))
    mixed = jnp.concatenate([attn_out, gla_o.reshape(B, T, GLA_V).astype(x.dtype)], axis=-1) @ w_out
    x = x + gate1 * mixed
    h = rmsnorm(x, norm2_g) * (1 + scale2) + shift2
    return x + gate2 * peer(h, peer_w_q, peer_keys, peer_u, peer_v)


def setup_inputs(seed: int = 0) -> dict:
    key = jax.random.key(seed)
    ks = jax.random.split(key, 20)
    f32 = jnp.float32
    D = D_MODEL

    def nrm(k, shape, scale):
        return jax.random.normal(k, shape, f32) * scale

    return {
        "x": nrm(ks[0], (BATCH, SEQ, D), 1.0),
        "c": nrm(ks[1], (BATCH, D), 1.0),
        "w_ada": nrm(ks[2], (DEPTH, D, N_MOD * D), 0.5 * D ** -0.5),
        "b_ada": nrm(ks[3], (DEPTH, N_MOD * D), 0.02),
        "norm1_g": 1.0 + nrm(ks[4], (DEPTH, D), 0.02),
        "norm2_g": 1.0 + nrm(ks[5], (DEPTH, D), 0.02),
        "w_in": nrm(ks[6], (DEPTH, D, IN_WIDTH), D ** -0.5),
        "attn_sinks": nrm(ks[7], (DEPTH, ATTN_HEADS), 0.5),
        "rel_bias": nrm(ks[8], (N_BUCKETS, ATTN_HEADS), 0.5),
        "gla_w_gk2": nrm(ks[9], (DEPTH, GLA_RANK, GLA_K), GLA_RANK ** -0.5),
        "gla_b_gk2": nrm(ks[10], (DEPTH, GLA_K), 0.02),
        "gla_norm_g": 1.0 + nrm(ks[11], (DEPTH, GLA_DV), 0.02),
        "w_out": nrm(ks[12], (DEPTH, MIX_WIDTH, D), MIX_WIDTH ** -0.5),
        "peer_w_q": nrm(ks[13], (DEPTH, D, PEER_HEADS * PEER_DKEY), D ** -0.5),
        "peer_keys": nrm(ks[14], (DEPTH, PEER_HEADS, 2, N_KEYS, PEER_DKEY // 2), (PEER_DKEY // 2) ** -0.5),
        "peer_u": nrm(ks[15], (DEPTH, N_EXPERTS, D), D ** -0.5),
        "peer_v": nrm(ks[16], (DEPTH, N_EXPERTS, D), PEER_HEADS ** -0.5),
        "final_g": 1.0 + nrm(ks[17], (D,), 0.02),
    }


def reference(x, c, w_ada, b_ada, norm1_g, norm2_g, w_in, attn_sinks, rel_bias,
              gla_w_gk2, gla_b_gk2, gla_norm_g, w_out, peer_w_q, peer_keys,
              peer_u, peer_v, final_g):
    c_act = jax.nn.silu(c)
    for l in range(DEPTH):
        mod = c_act @ w_ada[l] + b_ada[l]
        x = hybrid_layer(x, mod.astype(x.dtype), norm1_g[l], norm2_g[l], w_in[l],
                         attn_sinks[l], rel_bias, gla_w_gk2[l], gla_b_gk2[l],
                         gla_norm_g[l], w_out[l], peer_w_q[l], peer_keys[l],
                         peer_u[l], peer_v[l])
    return rmsnorm(x, final_g)
```

```cpp
#include <hip/hip_runtime.h>
#include <cstdio>
#include <cstdint>
namespace pg8 {
#define PG8_LAS __attribute__((address_space(3)))
typedef unsigned short bf16_t;
typedef short bf16x8 __attribute__((ext_vector_type(8)));
typedef float f32x4 __attribute__((ext_vector_type(4)));
typedef unsigned u32x4 __attribute__((ext_vector_type(4)));
constexpr int BM = 256, BK = 64, HALF = 128, HTB = HALF * BK * 2  , STAGE_BYTES = 8 * HTB, NXCD = 8, WGM = 8;

__host__ __device__ __forceinline__ int lds_byte(int r, int c) { const int st = (r >> 4) * 2 + (c >> 5), rr = r & 15, cc = c & 31, ob = rr * 64 + cc * 2; return st * 1024 + (ob ^ (((ob >> 9) & 1) << 5)); }
__host__ __device__ __forceinline__ void stage_rc(int b, int& R, int& C) { const int st = b / 1024, sb = b % 1024, swz = sb ^ (((sb >> 9) & 1) << 5); R = (st >> 1) * 16 + swz / 64; C = (st & 1) * 32 + (swz % 64) / 2; }
__host__ __device__ __forceinline__ int perm32(int rho) { const int n = rho >> 4, i = rho & 15; return 8 * (i >> 2) + 4 * n + (i & 3); }

struct Unit { int pm, pn; };
struct Gemm { const bf16_t* A; const bf16_t* Bt; int M, N, K; };

struct StaticOrder {
    int nM, nN, nwg, G, c;
    __host__ __device__ void init(int M, int N, int G_, int c_) { nM = M / BM; nN = N / BM; nwg = nM * nN; G = G_; c = c_; }
    __host__ __device__ bool next(int i, Unit& u) const {
        const long L = (long)i * G + c; if (L >= nwg) return false;
        int wgid = (int)L; { const int q = nwg / NXCD, r = nwg % NXCD, xcd = wgid % NXCD, off = wgid / NXCD; wgid = (xcd < r ? xcd * (q + 1) : r * (q + 1) + (xcd - r) * q) + off; }
        const int nig = WGM * nN, gid = wgid / nig, fm = gid * WGM, gsz = (nM - fm) < WGM ? (nM - fm) : WGM;
        u.pm = fm + ((wgid % nig) % gsz); u.pn = (wgid % nig) / gsz; return true;
    }
    __device__ __forceinline__ void a_ready(const Unit&) const {}
    __device__ __forceinline__ void done(const Unit&) const {}
};
__device__ __forceinline__ unsigned cvt_pk_bf16(float lo, float hi) { unsigned r; asm volatile("v_cvt_pk_bf16_f32 %0, %1, %2" : "=v"(r) : "v"(lo), "v"(hi)); return r; }
typedef float f32x2 __attribute__((ext_vector_type(2)));
__device__ __forceinline__ f32x2 gelu_pk(f32x2 v) {
    const f32x2 av = __builtin_elementwise_abs(v), d = av * 0.2316418882f + 1.0f;
    f32x2 t; t.x = __builtin_amdgcn_rcpf(d.x); t.y = __builtin_amdgcn_rcpf(d.y);
    f32x2 q = t * 0.5307027145f + (-0.7265760135f); q = q * t + 0.7107068705f; q = q * t + (-0.142248368f); q = q * t + 0.127414796f; q = q * t;
    const f32x2 s = (v * v) * (-0.72134752044f);
    f32x2 e; e.x = __builtin_amdgcn_exp2f(s.x); e.y = __builtin_amdgcn_exp2f(s.y);
    const f32x2 m = v * (q * e), r = v - m;
    f32x2 o; o.x = v.x < 0.f ? m.x : r.x; o.y = v.y < 0.f ? m.y : r.y; return o;
}

struct EpiF32 {
    static constexpr bool PERM = false, AFTER_DRAIN = false;
    float* C; int ldc; const float* bias;
    __device__ __forceinline__ void operator()(const f32x4 (&acc)[2][2][4][2], const Unit& u, int wr, int wc, int fr, int fq) const {
        const int row0 = u.pm * BM + wr * 64 + fr, col0 = u.pn * BM + wc * 32 + 4 * fq;
        f32x4 bv[2][2];
#pragma unroll
        for (int bj = 0; bj < 2; ++bj)
#pragma unroll
            for (int n = 0; n < 2; ++n) bv[bj][n] = bias ? *(const f32x4*)(bias + col0 + bj * HALF + n * 16) : (f32x4){0.f, 0.f, 0.f, 0.f};
#pragma unroll
        for (int ai = 0; ai < 2; ++ai)
#pragma unroll
            for (int m = 0; m < 4; ++m) { float* rowp = C + (size_t)(row0 + ai * HALF + m * 16) * ldc + col0;
#pragma unroll
                for (int bj = 0; bj < 2; ++bj)
#pragma unroll
                    for (int n = 0; n < 2; ++n) *(f32x4*)(rowp + bj * HALF + n * 16) = acc[ai][bj][m][n] + bv[bj][n]; }
    }
};
template <int ACT  > struct EpiBf16 {
    static constexpr bool PERM = true, AFTER_DRAIN = false;
    bf16_t* O; int ldc; const float* bias; int split_cols; size_t split_stride;
    __device__ __forceinline__ void operator()(const f32x4 (&acc)[2][2][4][2], const Unit& u, int wr, int wc, int fr, int fq) const {
        const int row0 = u.pm * BM + wr * 64 + fr; int colt = u.pn * BM; bf16_t* base = O;
        if (split_cols) { const int t = colt / split_cols; base += (size_t)t * split_stride; colt -= t * split_cols; }
        const int col0 = colt + wc * 32 + 8 * fq, bcol0 = u.pn * BM + wc * 32 + 8 * fq;
        f32x4 bv[2][2];
#pragma unroll
        for (int bj = 0; bj < 2; ++bj)
#pragma unroll
            for (int n = 0; n < 2; ++n) bv[bj][n] = bias ? *(const f32x4*)(bias + bcol0 + bj * HALF + 4 * n) : (f32x4){0.f, 0.f, 0.f, 0.f};
#pragma unroll
        for (int ai = 0; ai < 2; ++ai)
#pragma unroll
            for (int m = 0; m < 4; ++m) { bf16_t* rowp = base + (size_t)(row0 + ai * HALF + m * 16) * ldc + col0;
#pragma unroll
                for (int bj = 0; bj < 2; ++bj) { f32x4 v0 = acc[ai][bj][m][0] + bv[bj][0], v1 = acc[ai][bj][m][1] + bv[bj][1];
                    if (ACT == 1) { f32x2 a = gelu_pk((f32x2){v0[0], v0[1]}), b = gelu_pk((f32x2){v0[2], v0[3]}), c = gelu_pk((f32x2){v1[0], v1[1]}), d = gelu_pk((f32x2){v1[2], v1[3]});
                        v0 = (f32x4){a.x, a.y, b.x, b.y}; v1 = (f32x4){c.x, c.y, d.x, d.y}; }
                    if (ACT == 2) {
#pragma unroll
                        for (int j = 0; j < 4; ++j) { v0[j] = 0.5f * v0[j] * (1.0f + erff(v0[j] * 0.70710678f)); v1[j] = 0.5f * v1[j] * (1.0f + erff(v1[j] * 0.70710678f)); } }
                    u32x4 w; w.x = cvt_pk_bf16(v0[0], v0[1]); w.y = cvt_pk_bf16(v0[2], v0[3]); w.z = cvt_pk_bf16(v1[0], v1[1]); w.w = cvt_pk_bf16(v1[2], v1[3]);
                    *(u32x4*)(rowp + bj * HALF) = w; } }
    }
};
template <class Epi, class Sched, bool STAMP = false>
__device__ __forceinline__ void gemm_phase(PG8_LAS unsigned char* lds, const Gemm g, const Sched& S, const Epi& E, unsigned long long* stamps) {
    const int tid = threadIdx.x, wid = __builtin_amdgcn_readfirstlane(tid >> 6), lane = tid & 63, wr = wid >> 2, wc = wid & 3, fr = lane & 15, fq = lane >> 4;
    const int K = g.K, nt = K / BK;
    int ts_lo = 0, ts_hi = 0, nts = 0; const unsigned long long rt_entry = STAMP ? (unsigned long long)wall_clock64() : 0ull;
#define PG8_STAMP() do { if (STAMP && wid == 0 && nts < 64) { const unsigned long long _c = (unsigned long long)clock64(); \
        ts_lo = (lane == nts) ? (int)(unsigned)_c : ts_lo; ts_hi = (lane == nts) ? (int)(unsigned)(_c >> 32) : ts_hi; ++nts; } } while (0)
    PG8_STAMP();
    unsigned voffA[2], voffB[2];
#pragma unroll
    for (int i = 0; i < 2; ++i) { int R, C; stage_rc(tid * 16 + i * 8192, R, C); const int Rb = Epi::PERM ? ((R & ~31) + perm32(R & 31)) : R;
        voffA[i] = (unsigned)(R * K + C) * 2u; voffB[i] = (unsigned)(Rb * K + C) * 2u; }
    const size_t kstep = (size_t)(BK * 2);
    const size_t hstep = (size_t)HALF * K * 2;
    const size_t tstep = 2 * hstep;
    const unsigned ldsw = (unsigned)wid * 1024u;
    const int aoff = lds_byte(wr * 64 + fr, fq * 8), boff = lds_byte(wc * 32 + fr, fq * 8);
#define PG8_SA(b, h) (((b) * 2 + (h)) * HTB)
#define PG8_SB(b, h) ((4 + (b) * 2 + (h)) * HTB)
#define PG8_STAGE(bufoff, gbase, voff) do { _Pragma("unroll") for (int _i = 0; _i < 2; ++_i) \
        __builtin_amdgcn_global_load_lds((const unsigned*)((const char*)(gbase) + (voff)[_i]), (PG8_LAS unsigned*)(lds + (bufoff) + ldsw + _i * 8192), 16, 0, 0); } while (0)
#define PG8_LDA(dst, b, h) do { _Pragma("unroll") for (int m = 0; m < 4; ++m) _Pragma("unroll") for (int k = 0; k < 2; ++k) dst[m][k] = *(const PG8_LAS bf16x8*)(lds + PG8_SA(b, h) + aoff + m * 2048 + k * 1024); } while (0)
#define PG8_LDB(dst, b, h) do { _Pragma("unroll") for (int n = 0; n < 2; ++n) _Pragma("unroll") for (int k = 0; k < 2; ++k) dst[n][k] = *(const PG8_LAS bf16x8*)(lds + PG8_SB(b, h) + boff + n * 2048 + k * 1024); } while (0)
#define PG8_MMA(ai, bj, At, Bt) do { __builtin_amdgcn_s_setprio(1); _Pragma("unroll") for (int m = 0; m < 4; ++m) _Pragma("unroll") for (int n = 0; n < 2; ++n) _Pragma("unroll") for (int k = 0; k < 2; ++k) \
        acc[ai][bj][m][n] = __builtin_amdgcn_mfma_f32_16x16x32_bf16(Bt[n][k], At[m][k], acc[ai][bj][m][n], 0, 0, 0); __builtin_amdgcn_s_setprio(0); } while (0)
#define PG8_WAIT_V(n) asm volatile("s_waitcnt vmcnt(" #n ")" ::: "memory")
#define PG8_WAIT_L(n) asm volatile("s_waitcnt lgkmcnt(" #n ")" ::: "memory")
#define PG8_BAR __builtin_amdgcn_s_barrier()
#define PG8_SCHED __builtin_amdgcn_sched_barrier(0)
    Unit cur, nxt; int ui = 0;
    if (!S.next(0, cur)) return;
    f32x4 acc[2][2][4][2];
#pragma unroll
    for (int a = 0; a < 2; ++a)
#pragma unroll
        for (int b = 0; b < 2; ++b)
#pragma unroll
            for (int m = 0; m < 4; ++m)
#pragma unroll
                for (int n = 0; n < 2; ++n) acc[a][b][m][n] = (f32x4){0.f, 0.f, 0.f, 0.f};
    bf16x8 At[4][2], B0[2][2], B1[2][2];
    const char* cA = (const char*)g.A + (size_t)cur.pm * tstep; const char* cB = (const char*)g.Bt + (size_t)cur.pn * tstep;
    S.a_ready(cur);
    PG8_STAGE(PG8_SB(0, 0), cB, voffB); PG8_STAGE(PG8_SA(0, 0), cA, voffA); PG8_STAGE(PG8_SB(0, 1), cB + hstep, voffB); PG8_STAGE(PG8_SA(0, 1), cA + hstep, voffA);
    if (wr == 1) PG8_BAR;
    PG8_WAIT_V(4); PG8_BAR;
    PG8_STAGE(PG8_SB(1, 0), cB + kstep, voffB); PG8_STAGE(PG8_SA(1, 0), cA + kstep, voffA); PG8_STAGE(PG8_SB(1, 1), cB + hstep + kstep, voffB);
    PG8_WAIT_V(6); PG8_BAR;
    PG8_STAMP();
    for (;;) {
        const bool has_next = S.next(ui + 1, nxt);
        const char* nA = has_next ? (const char*)g.A + (size_t)nxt.pm * tstep : cA; const char* nB = has_next ? (const char*)g.Bt + (size_t)nxt.pn * tstep : cB;
        for (int t = 0; t < nt; t += 2) {
            const bool last = (t == nt - 2);
            const char* a1 = cA + (size_t)(t + 1) * kstep;
            const char* a2 = last ? nA : cA + (size_t)(t + 2) * kstep; const char* b2 = last ? nB : cB + (size_t)(t + 2) * kstep;
            const char* a3 = a2 + kstep; const char* b3 = b2 + kstep;
            if (last && has_next) S.a_ready(nxt);
            PG8_LDB(B0, 0, 0); PG8_SCHED; PG8_LDA(At, 0, 0); PG8_STAGE(PG8_SA(1, 1), a1 + hstep, voffA);
            PG8_WAIT_L(8); PG8_BAR; PG8_WAIT_L(0); PG8_MMA(0, 0, At, B0); PG8_BAR; PG8_SCHED;
            PG8_LDB(B1, 0, 1); PG8_STAGE(PG8_SB(0, 0), b2, voffB);
            PG8_BAR; PG8_WAIT_L(0); PG8_MMA(0, 1, At, B1); PG8_BAR;
            PG8_LDA(At, 0, 1); PG8_STAGE(PG8_SA(0, 0), a2, voffA);
            PG8_BAR; PG8_WAIT_L(0); PG8_MMA(1, 0, At, B0); PG8_BAR; PG8_SCHED;
            PG8_STAGE(PG8_SB(0, 1), b2 + hstep, voffB);
            PG8_WAIT_V(6); PG8_BAR; PG8_MMA(1, 1, At, B1); PG8_BAR;
            PG8_LDB(B0, 1, 0); PG8_SCHED; PG8_LDA(At, 1, 0); PG8_STAGE(PG8_SA(0, 1), a2 + hstep, voffA);
            PG8_WAIT_L(8); PG8_BAR; PG8_WAIT_L(0); PG8_MMA(0, 0, At, B0); PG8_BAR; PG8_SCHED;
            PG8_LDB(B1, 1, 1); PG8_STAGE(PG8_SB(1, 0), b3, voffB);
            PG8_BAR; PG8_WAIT_L(0); PG8_MMA(0, 1, At, B1); PG8_BAR;
            PG8_LDA(At, 1, 1); PG8_STAGE(PG8_SA(1, 0), a3, voffA);
            PG8_BAR; PG8_WAIT_L(0); PG8_MMA(1, 0, At, B0); PG8_BAR; PG8_SCHED;
            PG8_STAGE(PG8_SB(1, 1), b3 + hstep, voffB);
            PG8_WAIT_V(6); PG8_BAR; PG8_MMA(1, 1, At, B1); PG8_BAR;
        }
        PG8_STAMP();
        if constexpr (!Epi::AFTER_DRAIN) { E(acc, cur, wr, wc, fr, fq); S.done(cur); }
        PG8_STAMP();
        if (!has_next) break;
#pragma unroll
        for (int a = 0; a < 2; ++a)
#pragma unroll
            for (int b = 0; b < 2; ++b)
#pragma unroll
                for (int m = 0; m < 4; ++m)
#pragma unroll
                    for (int n = 0; n < 2; ++n) acc[a][b][m][n] = (f32x4){0.f, 0.f, 0.f, 0.f};
        cur = nxt; cA = nA; cB = nB; ++ui;
    }
    PG8_WAIT_V(0);
    if (wr == 0) PG8_BAR;
    PG8_BAR;
    if constexpr (Epi::AFTER_DRAIN) { E.fused(acc, cur, wr, wc, fr, fq, lds, wid, lane); S.done(cur); }
    PG8_STAMP();
    if (STAMP && wid == 0) { stamps[lane] = lane < nts ? (((unsigned long long)(unsigned)ts_hi << 32) | (unsigned)ts_lo) : 0ull;
        if (lane == 62) stamps[62] = rt_entry; if (lane == 63) stamps[63] = (unsigned long long)wall_clock64(); }
#undef PG8_STAMP
#undef PG8_SA
#undef PG8_SB
#undef PG8_STAGE
#undef PG8_LDA
#undef PG8_LDB
#undef PG8_MMA
#undef PG8_WAIT_V
#undef PG8_WAIT_L
#undef PG8_BAR
#undef PG8_SCHED
}
}

#ifndef MK_N_LAUNCHES
#define MK_N_LAUNCHES 10
#endif
constexpr int NPHASE = 10;
constexpr int NWAVES = 8, NTHR = 512;
constexpr int DM = 4096, NB = 4, SEQ = 2048, MTOK = NB * SEQ;
constexpr int IN_W = 8720, LDP = 8960;
constexpr int C_AQ = 0, C_AK = 2048, C_AV = 2304, C_GQ = 2560, C_GK = 3584, C_GV = 4608, C_GOUT = 6656, C_GLOW = 8704;
constexpr int NMOD = 6 * DM;
constexpr float EPS = 1e-6f;
constexpr int NEXP = 16384;

constexpr size_t MiB = 1u << 20;
constexpr size_t WS_CTL = 0, CTL_ZERO_BYTES = 1 * MiB;
constexpr size_t WS_MOD = 1 * MiB, WS_KEYS = 2 * MiB, WS_WIN = 4 * MiB, WS_WOUT = 74 * MiB, WS_WQ = 106 * MiB, WS_U = 122 * MiB, WS_V = 250 * MiB;
constexpr size_t WS_H = 378 * MiB, WS_PROJ = 442 * MiB, WS_QF = 582 * MiB, WS_KF = 598 * MiB, WS_AF = 614 * MiB, WS_DL = 618 * MiB, WS_VF = 619 * MiB;
constexpr size_t WS_O = 651 * MiB, WS_CAT = 715 * MiB, WS_X1 = 779 * MiB, WS_QB = 907 * MiB, WS_END = 939 * MiB;
constexpr int CW_BAR = 4096;

constexpr int LDS_BYTES = 147456;
constexpr int MISC_OFF = 0;
constexpr int PH_OFF = 256;

#define GAS __attribute__((address_space(1)))
#define LAS __attribute__((address_space(3)))
typedef unsigned short bf16;
typedef unsigned u32x4 __attribute__((ext_vector_type(4)));
typedef unsigned u32x2 __attribute__((ext_vector_type(2)));
typedef float f32x4 __attribute__((ext_vector_type(4)));
typedef short bf16x8 __attribute__((ext_vector_type(8)));
typedef __bf16 bf16x2_t __attribute__((ext_vector_type(2)));

__device__ __forceinline__ unsigned f2bf(float f) { unsigned u = __builtin_bit_cast(unsigned, f); return (u + 0x7fffu + ((u >> 16) & 1u)) >> 16; }
__device__ __forceinline__ unsigned pk2(float lo, float hi) { unsigned r; asm volatile("v_cvt_pk_bf16_f32 %0, %1, %2" : "=v"(r) : "v"(lo), "v"(hi)); return r; }
__device__ __forceinline__ float bf2f(unsigned short b) { return __builtin_bit_cast(float, (unsigned)b << 16); }
__device__ __forceinline__ float bflo(unsigned w) { return __builtin_bit_cast(float, w << 16); }
__device__ __forceinline__ float bfhi(unsigned w) { return __builtin_bit_cast(float, w & 0xffff0000u); }
__device__ __forceinline__ float wave_sum(float v) {
#pragma unroll
    for (int o = 1; o < 64; o <<= 1) v += __shfl_xor(v, o);
    return v;
}
__device__ __forceinline__ f32x4 mfma16(bf16x8 a, bf16x8 b, f32x4 c) { return __builtin_amdgcn_mfma_f32_16x16x32_bf16(a, b, c, 0, 0, 0); }
__device__ __forceinline__ float dot2bf(unsigned a, unsigned b, float c) { return __builtin_amdgcn_fdot2_f32_bf16(__builtin_bit_cast(bf16x2_t, a), __builtin_bit_cast(bf16x2_t, b), c, false); }

#define XB_TMO      128
#define XB_XCNT(j)  (256  + 64 * (j))
#define XB_XSUB(j)  (1280 + 64 * (j))
#define XB_XGEN(j)  (2304 + 64 * (j))
#define XB_TOP      3328
#define XB_TOPGEN   3392
#define XCD_BAR_WORDS 3456
#define XB_SPIN_CAP (1u << 18)

__device__ __forceinline__ unsigned xb_ld(unsigned* p)              { return __hip_atomic_load(p, __ATOMIC_RELAXED, __HIP_MEMORY_SCOPE_AGENT); }
__device__ __forceinline__ unsigned xb_add(unsigned* p, unsigned v) { return __hip_atomic_fetch_add(p, v, __ATOMIC_RELAXED, __HIP_MEMORY_SCOPE_AGENT); }
__device__ __forceinline__ unsigned xb_xcc_id() { return (unsigned)__builtin_amdgcn_s_getreg((3 << 11) | 20) & 0xFu; }
#define XB_SPIN(cond, bar) do { unsigned _sp = 0; while (cond) { __builtin_amdgcn_s_sleep(1); \
    if ((++_sp & 255u) == 0u) { if (xb_ld(&(bar)[XB_TMO])) break; if (_sp > XB_SPIN_CAP) { atomicAdd(&(bar)[XB_TMO], 1u); break; } } } } while (0)

struct XcdBarrier {
    unsigned* bar; unsigned x;
    volatile LAS unsigned* st;
};
__device__ __forceinline__ XcdBarrier xcd_barrier_post(unsigned* bar, volatile LAS unsigned* st) {
    XcdBarrier b; b.bar = bar; b.x = xb_xcc_id(); b.st = st;
    if (threadIdx.x == 0) (void)xb_add(&bar[XB_XCNT(b.x)], 1u);
    return b;
}
__device__ __forceinline__ void xcd_barrier_complete(unsigned* bar, unsigned x, unsigned& nloc, unsigned& nx) {
    const unsigned G = gridDim.x * gridDim.y * gridDim.z;
    unsigned sum, cnt, mine, sp = 0u;
    for (;;) {
        sum = 0u; cnt = 0u; mine = 0u;
#pragma unroll
        for (unsigned j = 0; j < 16; ++j) { const unsigned c = xb_ld(&bar[XB_XCNT(j)]); sum += c; cnt += (c > 0u) ? 1u : 0u; mine = (j == x) ? c : mine; }
        if (sum == G) break;
        __builtin_amdgcn_s_sleep(1);
        if ((++sp & 255u) == 0u) { if (xb_ld(&bar[XB_TMO])) break; if (sp > XB_SPIN_CAP) { atomicAdd(&bar[XB_TMO], 1u); break; } }
    }
    nloc = mine > 0u ? mine : 1u; nx = cnt > 0u ? cnt : 1u;
}
__device__ __forceinline__ void xcd_barrier(const XcdBarrier& b) {
    asm volatile("s_waitcnt vmcnt(0)" ::: "memory");
    __syncthreads();
    if (threadIdx.x == 0) {
        unsigned* bar = b.bar;
        __builtin_amdgcn_s_waitcnt(0);
        unsigned nloc = b.st[0], nx = b.st[1];
        if (nloc == 0u) { xcd_barrier_complete(bar, b.x, nloc, nx); b.st[0] = nloc; b.st[1] = nx; }
        const unsigned old = xb_add(&bar[XB_XSUB(b.x)], 1u);
        const unsigned gen = old / nloc;
        if (old + 1u == (gen + 1u) * nloc) {
            __builtin_amdgcn_fence(__ATOMIC_RELEASE, "agent");
            asm volatile("s_waitcnt vmcnt(0)" ::: "memory");
            const unsigned og = xb_add(&bar[XB_TOP], 1u);
            const unsigned tg = og / nx;
            if (og + 1u == (tg + 1u) * nx) xb_add(&bar[XB_TOPGEN], 1u);
            else XB_SPIN(xb_ld(&bar[XB_TOPGEN]) == tg, bar);
            __builtin_amdgcn_fence(__ATOMIC_ACQUIRE, "agent");
            xb_add(&bar[XB_XGEN(b.x)], 1u);
            asm volatile("s_waitcnt vmcnt(0)" ::: "memory");
        } else {
            XB_SPIN(xb_ld(&bar[XB_XGEN(b.x)]) == gen, bar);
            __builtin_amdgcn_fence(__ATOMIC_ACQUIRE, "agent");
            asm volatile("s_waitcnt vmcnt(0)" ::: "memory");
        }
    }
    __syncthreads();
}

struct Args { const float* in[18]; float* out; unsigned char* ws; int ph_lo, ph_hi, li, pad; };
struct Frame {
    LAS unsigned char* lds;
    int tid, lane, wave, G;
    const float* const* in; float* out; unsigned char* ws;
};
#define F_x        (F.in[0])
#define F_c        (F.in[1])
#define F_w_ada    (F.in[2])
#define F_b_ada    (F.in[3])
#define F_norm1_g  (F.in[4])
#define F_norm2_g  (F.in[5])
#define F_w_in     (F.in[6])
#define F_sinks    (F.in[7])
#define F_rel_bias (F.in[8])
#define F_gk2_w    (F.in[9])
#define F_gk2_b    (F.in[10])
#define F_gla_g    (F.in[11])
#define F_w_out    (F.in[12])
#define F_peer_wq  (F.in[13])
#define F_peer_keys (F.in[14])
#define F_peer_u   (F.in[15])
#define F_peer_v   (F.in[16])
#define F_final_g  (F.in[17])
#define F_out      (F.out)
#define F_mod      ((float*)(F.ws + WS_MOD))
#define F_keysb    ((bf16*)(F.ws + WS_KEYS))
#define F_win_t    ((bf16*)(F.ws + WS_WIN))
#define F_wout_t   ((bf16*)(F.ws + WS_WOUT))
#define F_wq_t     ((bf16*)(F.ws + WS_WQ))
#define F_ub       ((bf16*)(F.ws + WS_U))
#define F_vb       ((bf16*)(F.ws + WS_V))
#define F_hb       ((bf16*)(F.ws + WS_H))
#define F_proj     ((bf16*)(F.ws + WS_PROJ))
#define F_qf       ((bf16*)(F.ws + WS_QF))
#define F_kf       ((bf16*)(F.ws + WS_KF))
#define F_af       ((bf16*)(F.ws + WS_AF))
#define F_dl       ((float*)(F.ws + WS_DL))
#define F_vf       ((bf16*)(F.ws + WS_VF))
#define F_obuf     ((float*)(F.ws + WS_O))
#define F_cat      ((bf16*)(F.ws + WS_CAT))
#define F_x1       ((float*)(F.ws + WS_X1))
#define F_qb       ((bf16*)(F.ws + WS_QB))


__device__ __forceinline__ void p0_transpose_item(const float* W, int ldw, int K, int src_c0, bf16* WT, int dst_r0, int k0, LAS float* scr, int lane) {
#pragma unroll 8
    for (int i = 0; i < 32; ++i) { const int kk = 2 * i + (lane >> 5); scr[kk * 33 + (lane & 31)] = W[(size_t)(k0 + kk) * ldw + src_c0 + (lane & 31)]; }
    asm volatile("s_waitcnt lgkmcnt(0)" ::: "memory");
    const int c = lane & 7;
#pragma unroll
    for (int j = 0; j < 4; ++j) { const int n = (lane >> 3) + 8 * j; const LAS float* s = scr + (8 * c) * 33 + n;
        u32x4 o; o.x = pk2(s[0 * 33], s[1 * 33]); o.y = pk2(s[2 * 33], s[3 * 33]); o.z = pk2(s[4 * 33], s[5 * 33]); o.w = pk2(s[6 * 33], s[7 * 33]);
        *(u32x4*)(WT + (size_t)(dst_r0 + n) * K + k0 + 8 * c) = o; }
    asm volatile("s_waitcnt lgkmcnt(0)" ::: "memory");
}
__device__ __forceinline__ void cvt_rows(const float* src, bf16* dst, size_t n8, size_t i0, size_t stride) {
    for (size_t i = i0; i < n8; i += stride) { const f32x4 a = *(const f32x4*)(src + 8 * i), b = *(const f32x4*)(src + 8 * i + 4);
        u32x4 o; o.x = pk2(a.x, a.y); o.y = pk2(a.z, a.w); o.z = pk2(b.x, b.y); o.w = pk2(b.z, b.w); *(u32x4*)(dst + 8 * i) = o; }
}
__device__ __forceinline__ void p0_prologue(Frame& F) {
    const int tid = F.tid, lane = F.lane, wave = F.wave;
    {
        LAS float* sc = (LAS float*)(F.lds + PH_OFF);
        LAS float* red = sc + 4 * DM;
        for (int i = tid; i < 4 * DM; i += NTHR) { const float v = F_c[i]; sc[i] = v / (1.f + __expf(-v)); }
        __syncthreads();
        for (int slab = blockIdx.x; slab < NMOD / 96; slab += F.G) {
            const int cg = tid % 24, kg = tid / 24;
            if (kg < 21) {
                f32x4 acc[4];
#pragma unroll
                for (int b = 0; b < 4; ++b) acc[b] = (f32x4){0.f, 0.f, 0.f, 0.f};
                const float* wp = F_w_ada + (size_t)kg * NMOD + slab * 96 + cg * 4;
#pragma unroll 4
                for (int k = kg; k < DM; k += 21) { const f32x4 w = *(const f32x4*)wp; wp += (size_t)21 * NMOD;
#pragma unroll
                    for (int b = 0; b < 4; ++b) acc[b] += w * sc[b * DM + k]; }
#pragma unroll
                for (int b = 0; b < 4; ++b) *(LAS f32x4*)(red + (kg * 4 + b) * 96 + cg * 4) = acc[b];
            }
            __syncthreads();
            if (tid < 384) { const int b = tid / 96, col = tid % 96; float s = F_b_ada[slab * 96 + col];
                for (int kg2 = 0; kg2 < 21; ++kg2) s += red[(kg2 * 4 + b) * 96 + col];
                F_mod[b * NMOD + slab * 96 + col] = s; }
            __syncthreads();
        }
    }
    {
        LAS float* scr = (LAS float*)(F.lds + PH_OFF + wave * 8448);
        const int gw = blockIdx.x * NWAVES + wave, NGW = F.G * NWAVES;
        constexpr int I_IN = 64 * 272, I_OUT = 64 * 128, I_Q = 64 * 64;
        for (int it = gw; it < I_IN + I_OUT + I_Q; it += NGW) {
            int r = it;
            if (r < I_IN) { const int kb = r / 272, nb = r % 272, r0 = nb * 32; p0_transpose_item(F_w_in, IN_W, DM, r0 < 6656 ? r0 : r0 + 16, F_win_t, r0, kb * 64, scr, lane); continue; } r -= I_IN;
            if (r < I_OUT) { const int kb = r / 128, nb = r % 128; p0_transpose_item(F_w_out, DM, DM, nb * 32, F_wout_t, nb * 32, kb * 64, scr, lane); continue; } r -= I_OUT;
            { const int kb = r / 64, nb = r % 64; p0_transpose_item(F_peer_wq, 2048, DM, nb * 32, F_wq_t, nb * 32, kb * 64, scr, lane); }
        }
        const size_t gt = (size_t)blockIdx.x * NTHR + tid, NT = (size_t)F.G * NTHR;
        for (size_t i = gt; i < (size_t)256 * DM / 8; i += NT) { const int row = (int)(i / (DM / 8)), kc = (int)(i % (DM / 8)) * 8;
            u32x4 o = {0u, 0u, 0u, 0u};
            if (row < 16) { float v[8];
#pragma unroll
                for (int j = 0; j < 8; ++j) v[j] = F_w_in[(size_t)(kc + j) * IN_W + 6656 + row];
                o.x = pk2(v[0], v[1]); o.y = pk2(v[2], v[3]); o.z = pk2(v[4], v[5]); o.w = pk2(v[6], v[7]); }
            *(u32x4*)(F_win_t + (size_t)(8704 + row) * DM + kc) = o; }
        cvt_rows(F_peer_u, F_ub, (size_t)NEXP * DM / 8, gt, NT);
        cvt_rows(F_peer_v, F_vb, (size_t)NEXP * DM / 8, gt, NT);
        cvt_rows(F_peer_keys, F_keysb, (size_t)8 * 2 * 128 * 128 / 8, gt, NT);
    }
}

__device__ __forceinline__ void norm_mod_phase(Frame& F, const float* xin, const float* g, int shift_off, int scale_off, bf16* outp) {
    const int gw = blockIdx.x * NWAVES + F.wave, NGW = F.G * NWAVES, lane = F.lane;
    for (int row = gw; row < MTOK; row += NGW) {
        const int b = row / SEQ;
        const f32x4* xr = (const f32x4*)(xin + (size_t)row * DM) + lane;
        f32x4 v[16]; float ss = 0.f;
#pragma unroll
        for (int j = 0; j < 16; ++j) { v[j] = xr[64 * j]; ss += (v[j].x * v[j].x + v[j].y * v[j].y) + (v[j].z * v[j].z + v[j].w * v[j].w); }
        const float rstd = rsqrtf(wave_sum(ss) * (1.f / DM) + EPS);
        const float* mb = F_mod + (size_t)b * NMOD;
        u32x2* op = (u32x2*)(outp + (size_t)row * DM) + lane;
#pragma unroll
        for (int j = 0; j < 16; ++j) { const int col = (lane + 64 * j) * 4;
            const f32x4 gv = *(const f32x4*)(g + col), sc = *(const f32x4*)(mb + scale_off + col), sh = *(const f32x4*)(mb + shift_off + col);
            const f32x4 y = (v[j] * rstd) * gv * (sc + 1.f) + sh;
            u32x2 o; o.x = pk2(y.x, y.y); o.y = pk2(y.z, y.w); op[64 * j] = o; }
    }
}

__device__ __forceinline__ int t5_bucket(int d) {
    if (d < 16) return d;
    const int v = 16 + (int)(__log2f((float)d * (1.f / 16.f)) * (16.f / 3.f));
    return v < 31 ? v : 31;
}
constexpr int VT_LD = 296;
__device__ __forceinline__ void swa_item(Frame& F, int item) {
    const int tid = F.tid, lane = F.lane, w = F.wave, g = lane >> 4, r = lane & 15;
    const int hg = item & 1, n = (item >> 1) & 15, kvh = (item >> 5) & 1, b = item >> 6;
    LAS unsigned short* Vt = (LAS unsigned short*)(F.lds + PH_OFF);
    LAS float* btab = (LAS float*)(F.lds + PH_OFF + 128 * VT_LD * 2);
    const int tok0 = b * SEQ + n * 128, tokmin = b * SEQ;
    for (int idx = tid; idx < 256 * 16; idx += NTHR) { const int kj = idx >> 4, c = idx & 15;
        int tk = tok0 - 128 + kj; tk = tk < tokmin ? tokmin : tk;
        const u32x4 v = *(const u32x4*)(F_proj + (size_t)tk * LDP + C_AV + kvh * 128 + 8 * c);
        LAS unsigned short* vp = Vt + (8 * c) * VT_LD + kj;
        vp[0 * VT_LD] = (unsigned short)(v.x & 0xffffu); vp[1 * VT_LD] = (unsigned short)(v.x >> 16);
        vp[2 * VT_LD] = (unsigned short)(v.y & 0xffffu); vp[3 * VT_LD] = (unsigned short)(v.y >> 16);
        vp[4 * VT_LD] = (unsigned short)(v.z & 0xffffu); vp[5 * VT_LD] = (unsigned short)(v.z >> 16);
        vp[6 * VT_LD] = (unsigned short)(v.w & 0xffffu); vp[7 * VT_LD] = (unsigned short)(v.w >> 16); }
    for (int idx = tid; idx < 128 * 40; idx += NTHR) Vt[(idx / 40) * VT_LD + 256 + idx % 40] = 0;
    for (int idx = tid; idx < 4 * 128; idx += NTHR) { const int hh = idx >> 7, dist = idx & 127; btab[idx] = F_rel_bias[t5_bucket(dist) * 16 + kvh * 8 + hg * 4 + hh]; }
    __syncthreads();
    constexpr float SCALE = 0.08838834764831845f;
    const int lb = 4 * g + 16 * w - (n == 0 ? 128 : 0), lrel = 4 * g - r;
#pragma unroll 1
    for (int hh = 0; hh < 4; ++hh) {
        const int h = kvh * 8 + hg * 4 + hh;
        const float sink = F_sinks[h];
        bf16x8 qfr[4];
        { const bf16* qp = F_proj + (size_t)(tok0 + 16 * w + r) * LDP + C_AQ + h * 128 + 8 * g;
#pragma unroll
          for (int ks = 0; ks < 4; ++ks) qfr[ks] = *(const bf16x8*)(qp + 32 * ks); }
        float s[9][4];
#pragma unroll
        for (int t = 0; t < 9; ++t) {
            const int kj0 = 16 * (w + t);
            int tk = tok0 - 128 + kj0 + r; tk = tk < tokmin ? tokmin : tk;
            const bf16* kp = F_proj + (size_t)tk * LDP + C_AK + kvh * 128 + 8 * g;
            f32x4 acc = {0.f, 0.f, 0.f, 0.f};
#pragma unroll
            for (int ks = 0; ks < 4; ++ks) acc = mfma16(*(const bf16x8*)(kp + 32 * ks), qfr[ks], acc);
#pragma unroll
            for (int reg = 0; reg < 4; ++reg) { const int rel = lrel + 16 * t + reg;
                const bool ok = (rel > 0) && (rel <= 128) && (lb + 16 * t + reg >= 0);
                s[t][reg] = ok ? acc[reg] * SCALE + btab[hh * 128 + ((128 - rel) & 127)] : -1e30f; }
        }
        float m = sink;
#pragma unroll
        for (int t = 0; t < 9; ++t)
#pragma unroll
            for (int reg = 0; reg < 4; ++reg) m = fmaxf(m, s[t][reg]);
        m = fmaxf(m, __shfl_xor(m, 16)); m = fmaxf(m, __shfl_xor(m, 32));
        float sum = 0.f;
#pragma unroll
        for (int t = 0; t < 9; ++t)
#pragma unroll
            for (int reg = 0; reg < 4; ++reg) { s[t][reg] = __expf(s[t][reg] - m); sum += s[t][reg]; }
        sum += __shfl_xor(sum, 16); sum += __shfl_xor(sum, 32);
        const float inv = 1.f / (sum + __expf(sink - m));
        f32x4 o[8];
#pragma unroll
        for (int dt = 0; dt < 8; ++dt) o[dt] = (f32x4){0.f, 0.f, 0.f, 0.f};
#pragma unroll
        for (int s5 = 0; s5 < 5; ++s5) {
            u32x4 pw; pw.x = pk2(s[2 * s5][0], s[2 * s5][1]); pw.y = pk2(s[2 * s5][2], s[2 * s5][3]);
            if (2 * s5 + 1 < 9) { pw.z = pk2(s[(2 * s5 + 1) % 9][0], s[(2 * s5 + 1) % 9][1]); pw.w = pk2(s[(2 * s5 + 1) % 9][2], s[(2 * s5 + 1) % 9][3]); } else { pw.z = 0u; pw.w = 0u; }
            const bf16x8 pf = __builtin_bit_cast(bf16x8, pw);
            const int kb = 16 * w + 32 * s5 + 4 * g;
#pragma unroll
            for (int dt = 0; dt < 8; ++dt) { const LAS unsigned short* vp = Vt + (16 * dt + r) * VT_LD + kb;
                const u32x2 lo = *(const LAS u32x2*)vp, hi = *(const LAS u32x2*)(vp + 16);
                u32x4 va; va.x = lo.x; va.y = lo.y; va.z = hi.x; va.w = hi.y;
                o[dt] = mfma16(__builtin_bit_cast(bf16x8, va), pf, o[dt]); }
        }
        bf16* op = F_cat + (size_t)(tok0 + 16 * w + r) * DM + h * 128 + 4 * g;
#pragma unroll
        for (int dt = 0; dt < 8; ++dt) { u32x2 ov; ov.x = pk2(o[dt][0] * inv, o[dt][1] * inv); ov.y = pk2(o[dt][2] * inv, o[dt][3] * inv); *(u32x2*)(op + 16 * dt) = ov; }
    }
    __syncthreads();
}

constexpr int QD_LD = 264;
__device__ __forceinline__ void gla_prep_item(Frame& F, int item) {
    const int tid = F.tid, lane = F.lane, w = F.wave, g = lane >> 4, r = lane & 15;
    const int n = item & 31, h = (item >> 5) & 3, b = item >> 7;
    const int tok0 = b * SEQ + n * 64;
    LAS float* glw = (LAS float*)(F.lds + PH_OFF);
    LAS float* bc = glw + 1024;
    LAS unsigned short* qd = (LAS unsigned short*)(bc + 64 * 256);
    LAS unsigned short* ki = qd + 64 * QD_LD;
    for (int idx = tid; idx < 1024; idx += NTHR) glw[idx] = bf2f(F_proj[(size_t)(tok0 + (idx >> 4)) * LDP + C_GLOW + (idx & 15)]);
    __syncthreads();
    const int d = tid & 255, half = tid >> 8;
    {
        float wv[16];
#pragma unroll
        for (int q = 0; q < 16; ++q) wv[q] = F_gk2_w[q * 1024 + h * 256 + d];
        const float bias = F_gk2_b[h * 256 + d];
        float run = 0.f;
        for (int tt = 0; tt < 32; ++tt) { const int t = half * 32 + tt; float z = bias;
#pragma unroll
            for (int q = 0; q < 16; ++q) z += glw[t * 16 + q] * wv[q];
            const float ls = fminf(z, 0.f) - log1pf(__expf(-fabsf(z)));
            run += ls * (1.f / 16.f); bc[t * 256 + d] = run; }
    }
    __syncthreads();
    {
        const float off = half ? bc[31 * 256 + d] : 0.f;
        const float blast = bc[63 * 256 + d] + bc[31 * 256 + d];
        bf16* qfp = F_qf + (size_t)item * 16384; bf16* kfp = F_kf + (size_t)item * 16384;
        const int T = d >> 5, rr = d & 31, gq = (rr & 15) >> 2, jq = (rr & 3) + ((rr >> 4) << 2), dkt = d >> 4, di = d & 15;
        for (int tt = 0; tt < 32; ++tt) { const int t = half * 32 + tt; const float bt = bc[t * 256 + d] + off; const size_t tok = tok0 + t;
            const float q = bf2f(F_proj[tok * LDP + C_GQ + h * 256 + d]), k = bf2f(F_proj[tok * LDP + C_GK + h * 256 + d]);
            const float qdv = q * (1.f / 16.f) * __expf(bt), kiv = k * __expf(-bt), kdv = k * __expf(blast - bt);
            const unsigned short qb16 = (unsigned short)f2bf(qdv);
            qd[t * QD_LD + d] = qb16; ki[t * QD_LD + d] = (unsigned short)f2bf(kiv);
            qfp[((T * 4 + (t >> 4)) * 64 + gq * 16 + (t & 15)) * 8 + jq] = qb16;
            kfp[((dkt * 2 + (t >> 5)) * 64 + ((t & 31) >> 3) * 16 + di) * 8 + (t & 7)] = (unsigned short)f2bf(kdv); }
        if (half == 0) F_dl[(size_t)item * 256 + d] = __expf(blast);
    }
    __syncthreads();
    {
        bf16* afp = F_af + (size_t)item * 4096;
        for (int tile = w; tile < 16; tile += 8) { const int ti = tile >> 2, tj = tile & 3;
            f32x4 acc = {0.f, 0.f, 0.f, 0.f};
            if (tj <= ti) {
#pragma unroll
                for (int ks = 0; ks < 8; ++ks) acc = mfma16(*(const LAS bf16x8*)(qd + (16 * ti + r) * QD_LD + 32 * ks + 8 * g), *(const LAS bf16x8*)(ki + (16 * tj + r) * QD_LD + 32 * ks + 8 * g), acc); }
#pragma unroll
            for (int reg = 0; reg < 4; ++reg) { const int row = 16 * ti + 4 * g + reg, col = 16 * tj + r;
                const float val = (tj <= ti && row >= col) ? acc[reg] : 0.f;
                afp[(((row >> 4) * 2 + (col >> 5)) * 64 + ((col & 31) >> 3) * 16 + (row & 15)) * 8 + (col & 7)] = (unsigned short)f2bf(val); }
        }
        bf16* vfp = F_vf + (size_t)item * 32768;
        for (int idx = tid; idx < 64 * 64; idx += NTHR) { const int t = idx >> 6, c = idx & 63;
            const u32x4 v = *(const u32x4*)(F_proj + (size_t)(tok0 + t) * LDP + C_GV + h * 512 + 8 * c);
            const int base = ((t >> 5) * 64 + ((t & 31) >> 3) * 16) * 8 + (t & 7);
            const unsigned vw[4] = {v.x, v.y, v.z, v.w};
#pragma unroll
            for (int e = 0; e < 8; ++e) { const int dv = 8 * c + e; vfp[(dv >> 4) * 1024 + base + (dv & 15) * 8] = (unsigned short)((e & 1) ? (vw[e >> 1] >> 16) : (vw[e >> 1] & 0xffffu)); } }
    }
    __syncthreads();
}

__device__ __forceinline__ void gla_scan_item(Frame& F, int item) {
    if (F.wave >= 2) return;
    const int lane = F.lane, g = lane >> 4, r = lane & 15;
    const int bh = item >> 4, dvt = (item & 15) * 2 + F.wave, b = bh >> 2, h = bh & 3;
    f32x4 S[16];
#pragma unroll
    for (int i = 0; i < 16; ++i) S[i] = (f32x4){0.f, 0.f, 0.f, 0.f};
    for (int n = 0; n < 32; ++n) {
        const size_t chunk = (size_t)bh * 32 + n;
        const bf16x8* qfp = (const bf16x8*)(F_qf + chunk * 16384) + lane;
        const bf16x8* kfp = (const bf16x8*)(F_kf + chunk * 16384) + lane;
        const bf16x8* afp = (const bf16x8*)(F_af + chunk * 4096) + lane;
        const bf16x8* vfp = (const bf16x8*)(F_vf + chunk * 32768) + (dvt * 2) * 64 + lane;
        const bf16x8 vb0 = vfp[0], vb1 = vfp[64];
        f32x4 o[4];
#pragma unroll
        for (int tt = 0; tt < 4; ++tt) o[tt] = (f32x4){0.f, 0.f, 0.f, 0.f};
#pragma unroll
        for (int T = 0; T < 8; ++T) {
            u32x4 sw; sw.x = pk2(S[2 * T][0], S[2 * T][1]); sw.y = pk2(S[2 * T][2], S[2 * T][3]); sw.z = pk2(S[2 * T + 1][0], S[2 * T + 1][1]); sw.w = pk2(S[2 * T + 1][2], S[2 * T + 1][3]);
            const bf16x8 sb = __builtin_bit_cast(bf16x8, sw);
#pragma unroll
            for (int tt = 0; tt < 4; ++tt) o[tt] = mfma16(qfp[(T * 4 + tt) * 64], sb, o[tt]);
        }
#pragma unroll
        for (int tt = 0; tt < 4; ++tt) { o[tt] = mfma16(afp[(tt * 2 + 0) * 64], vb0, o[tt]); o[tt] = mfma16(afp[(tt * 2 + 1) * 64], vb1, o[tt]); }
        float* op = F_obuf + (size_t)(b * SEQ + n * 64 + 4 * g) * 2048 + h * 512 + 16 * dvt + r;
#pragma unroll
        for (int tt = 0; tt < 4; ++tt)
#pragma unroll
            for (int reg = 0; reg < 4; ++reg) op[(size_t)(16 * tt + reg) * 2048] = o[tt][reg];
        const float* dlp = F_dl + chunk * 256 + 4 * g;
#pragma unroll
        for (int dkt = 0; dkt < 16; ++dkt) { const f32x4 d4 = *(const f32x4*)(dlp + 16 * dkt);
            S[dkt] = S[dkt] * d4;
            S[dkt] = mfma16(kfp[(dkt * 2 + 0) * 64], vb0, S[dkt]); S[dkt] = mfma16(kfp[(dkt * 2 + 1) * 64], vb1, S[dkt]); }
    }
}

__device__ __forceinline__ void gla_norm_phase(Frame& F) {
    const int gw = blockIdx.x * NWAVES + F.wave, NGW = F.G * NWAVES, lane = F.lane;
    const f32x4 g0 = *(const f32x4*)(F_gla_g + lane * 8), g1 = *(const f32x4*)(F_gla_g + lane * 8 + 4);
    for (int pr = gw; pr < MTOK * 4; pr += NGW) { const int tok = pr >> 2, h = pr & 3;
        const float* op = F_obuf + (size_t)tok * 2048 + h * 512 + lane * 8;
        const f32x4 a = *(const f32x4*)op, bq = *(const f32x4*)(op + 4);
        const float ss = (a.x * a.x + a.y * a.y) + (a.z * a.z + a.w * a.w) + (bq.x * bq.x + bq.y * bq.y) + (bq.z * bq.z + bq.w * bq.w);
        const float rstd = rsqrtf(wave_sum(ss) * (1.f / 512.f) + EPS);
        const u32x4 gw4 = *(const u32x4*)(F_proj + (size_t)tok * LDP + C_GOUT + h * 512 + lane * 8);
        float go[8] = {bflo(gw4.x), bfhi(gw4.x), bflo(gw4.y), bfhi(gw4.y), bflo(gw4.z), bfhi(gw4.z), bflo(gw4.w), bfhi(gw4.w)};
        float y[8] = {a.x * g0.x, a.y * g0.y, a.z * g0.z, a.w * g0.w, bq.x * g1.x, bq.y * g1.y, bq.z * g1.z, bq.w * g1.w};
#pragma unroll
        for (int e = 0; e < 8; ++e) y[e] = y[e] * rstd * (go[e] / (1.f + __expf(-go[e])));
        u32x4 o; o.x = pk2(y[0], y[1]); o.y = pk2(y[2], y[3]); o.z = pk2(y[4], y[5]); o.w = pk2(y[6], y[7]);
        *(u32x4*)(F_cat + (size_t)tok * DM + 2048 + h * 512 + lane * 8) = o; }
}

struct EpiResid {
    static constexpr bool PERM = false, AFTER_DRAIN = false;
    const float* x; const float* mod; float* x1;
    __device__ __forceinline__ void operator()(const pg8::f32x4 (&acc)[2][2][4][2], const pg8::Unit& u, int wr, int wc, int fr, int fq) const {
        const int row0 = u.pm * 256 + wr * 64 + fr, col0 = u.pn * 256 + wc * 32 + 4 * fq;
        const int b = (u.pm * 256) / SEQ;
        const float* gp = mod + (size_t)b * NMOD + 2 * DM + col0;
        pg8::f32x4 gv[2][2];
#pragma unroll
        for (int bj = 0; bj < 2; ++bj)
#pragma unroll
            for (int n = 0; n < 2; ++n) gv[bj][n] = *(const pg8::f32x4*)(gp + bj * 128 + n * 16);
#pragma unroll
        for (int ai = 0; ai < 2; ++ai)
#pragma unroll
            for (int m = 0; m < 4; ++m) { const size_t off = (size_t)(row0 + ai * 128 + m * 16) * DM + col0;
#pragma unroll
                for (int bj = 0; bj < 2; ++bj)
#pragma unroll
                    for (int n = 0; n < 2; ++n) { const pg8::f32x4 xv = *(const pg8::f32x4*)(x + off + bj * 128 + n * 16);
                        *(pg8::f32x4*)(x1 + off + bj * 128 + n * 16) = xv + gv[bj][n] * acc[ai][bj][m][n]; } }
    }
};

__device__ __forceinline__ float gelu_erf(float v) { return 0.5f * v * (1.f + erff(v * 0.70710678118654752f)); }
__device__ __forceinline__ void wave_argmax(float& bv, int& bi) {
#pragma unroll
    for (int o = 32; o >= 1; o >>= 1) { const float ov = __shfl_xor(bv, o); const int oi = __shfl_xor(bi, o); if (ov > bv || (ov == bv && oi < bi)) { bv = ov; bi = oi; } }
}
__device__ __forceinline__ void peer_phase(Frame& F) {
    const int tid = F.tid, lane = F.lane, w = F.wave, g = lane >> 4, r = lane & 15;
    LAS float* sc = (LAS float*)(F.lds + PH_OFF);
    LAS int* pidx = (LAS int*)(sc + 32 * 256);
    LAS float* pgate = (LAS float*)(pidx + 32 * 128);
    const float NEG = -3.0e38f;
    for (int grp = blockIdx.x; grp < MTOK / 32; grp += F.G) {
        const int tok0 = grp * 32;
#pragma unroll 1
        for (int h = 0; h < 8; ++h) {
            for (int tile = w; tile < 32; tile += 8) { const int kt = tile & 7, p = (tile >> 3) & 1, tt = tile >> 4;
                const bf16* qp = F_qb + (size_t)(tok0 + 16 * tt + r) * 2048 + h * 256 + p * 128 + 8 * g;
                const bf16* kp = F_keysb + (size_t)((h * 2 + p) * 128 + 16 * kt + r) * 128 + 8 * g;
                f32x4 acc = {0.f, 0.f, 0.f, 0.f};
#pragma unroll
                for (int ks = 0; ks < 4; ++ks) acc = mfma16(*(const bf16x8*)(qp + 32 * ks), *(const bf16x8*)(kp + 32 * ks), acc);
#pragma unroll
                for (int reg = 0; reg < 4; ++reg) sc[((16 * tt + 4 * g + reg) * 2 + p) * 128 + 16 * kt + r] = acc[reg];
            }
            __syncthreads();
            for (int tl = w; tl < 32; tl += 8) {
                float s1 = NEG, s2 = NEG; int i1 = 0, i2 = 0;
#pragma unroll
                for (int p = 0; p < 2; ++p) {
                    float v0 = sc[(tl * 2 + p) * 128 + lane], v1 = sc[(tl * 2 + p) * 128 + 64 + lane];
                    float rs = NEG; int ri = 0;
#pragma unroll 1
                    for (int k = 0; k < 16; ++k) {
                        float bv; int bi; if (v1 > v0) { bv = v1; bi = lane + 64; } else { bv = v0; bi = lane; }
                        wave_argmax(bv, bi);
                        if (lane == k) { rs = bv; ri = bi; }
                        if (bi == lane) v0 = NEG; if (bi == lane + 64) v1 = NEG;
                    }
                    if (p == 0) { s1 = rs; i1 = ri; } else { s2 = rs; i2 = ri; }
                }
                float cv[4];
#pragma unroll
                for (int q = 0; q < 4; ++q) { const int c = lane + 64 * q; cv[q] = __shfl(s1, c >> 4) + __shfl(s2, c & 15); }
                float ts = NEG; int tc = 0;
#pragma unroll 1
                for (int k = 0; k < 16; ++k) {
                    float bv = cv[0]; int bi = lane;
#pragma unroll
                    for (int q = 1; q < 4; ++q) if (cv[q] > bv) { bv = cv[q]; bi = lane + 64 * q; }
                    wave_argmax(bv, bi);
                    if (lane == k) { ts = bv; tc = bi; }
#pragma unroll
                    for (int q = 0; q < 4; ++q) if (bi == lane + 64 * q) cv[q] = NEG;
                }
                const int e1 = __shfl(i1, tc >> 4), e2 = __shfl(i2, tc & 15);
                const float mx = __shfl(ts, 0);
                float ex = lane < 16 ? __expf(ts - mx) : 0.f;
                float den = ex;
#pragma unroll
                for (int o = 8; o >= 1; o >>= 1) den += __shfl_xor(den, o);
                if (lane < 16) { pidx[tl * 128 + h * 16 + lane] = e1 * 128 + e2; pgate[tl * 128 + h * 16 + lane] = ex / den; }
            }
            __syncthreads();
        }
#pragma unroll 1
        for (int tq = 0; tq < 4; ++tq) { const int tl = w * 4 + tq, tok = tok0 + tl, b = tok / SEQ;
            u32x4 hv[8];
            { const u32x4* hp = (const u32x4*)(F_hb + (size_t)tok * DM) + lane;
#pragma unroll
              for (int i = 0; i < 8; ++i) hv[i] = hp[64 * i]; }
            float wlo = 0.f, whi = 0.f;
#pragma unroll 1
            for (int e = 0; e < 128; ++e) {
                const int id0 = pidx[tl * 128 + e];
                const u32x4* u0 = (const u32x4*)(F_ub + (size_t)id0 * DM) + lane;
                u32x4 a0[8];
#pragma unroll
                for (int i = 0; i < 8; ++i) a0[i] = u0[64 * i];
                float d0 = 0.f, d1 = 0.f;
#pragma unroll
                for (int i = 0; i < 8; ++i) { d0 = dot2bf(a0[i].x, hv[i].x, d0); d1 = dot2bf(a0[i].y, hv[i].y, d1); d0 = dot2bf(a0[i].z, hv[i].z, d0); d1 = dot2bf(a0[i].w, hv[i].w, d1); }
                d0 = wave_sum(d0 + d1);
                const float w0 = pgate[tl * 128 + e] * gelu_erf(d0);
                if (lane == (e & 63)) { if (e < 64) wlo = w0; else whi = w0; }
            }
            float acc[8][8];
#pragma unroll
            for (int i = 0; i < 8; ++i)
#pragma unroll
                for (int j = 0; j < 8; ++j) acc[i][j] = 0.f;
#pragma unroll 1
            for (int e = 0; e < 128; ++e) {
                const int id0 = pidx[tl * 128 + e];
                const float w0 = __shfl(e < 64 ? wlo : whi, e & 63);
                const u32x4* v0 = (const u32x4*)(F_vb + (size_t)id0 * DM) + lane;
                u32x4 a0[8];
#pragma unroll
                for (int i = 0; i < 8; ++i) a0[i] = v0[64 * i];
#pragma unroll
                for (int i = 0; i < 8; ++i) {
                    acc[i][0] += w0 * bflo(a0[i].x); acc[i][1] += w0 * bfhi(a0[i].x); acc[i][2] += w0 * bflo(a0[i].y); acc[i][3] += w0 * bfhi(a0[i].y);
                    acc[i][4] += w0 * bflo(a0[i].z); acc[i][5] += w0 * bfhi(a0[i].z); acc[i][6] += w0 * bflo(a0[i].w); acc[i][7] += w0 * bfhi(a0[i].w); }
            }
            const float* g2p = F_mod + (size_t)b * NMOD + 5 * DM;
            const float* x1p = F_x1 + (size_t)tok * DM;
            float ss = 0.f;
#pragma unroll
            for (int i = 0; i < 8; ++i) { const int col = (i * 64 + lane) * 8;
                const f32x4 xa = *(const f32x4*)(x1p + col), xb = *(const f32x4*)(x1p + col + 4), ga = *(const f32x4*)(g2p + col), gb = *(const f32x4*)(g2p + col + 4);
                acc[i][0] = xa.x + ga.x * acc[i][0]; acc[i][1] = xa.y + ga.y * acc[i][1]; acc[i][2] = xa.z + ga.z * acc[i][2]; acc[i][3] = xa.w + ga.w * acc[i][3];
                acc[i][4] = xb.x + gb.x * acc[i][4]; acc[i][5] = xb.y + gb.y * acc[i][5]; acc[i][6] = xb.z + gb.z * acc[i][6]; acc[i][7] = xb.w + gb.w * acc[i][7];
#pragma unroll
                for (int j = 0; j < 8; ++j) ss += acc[i][j] * acc[i][j];
                asm volatile("" ::: "memory"); }
            const float rstd = rsqrtf(wave_sum(ss) * (1.f / DM) + EPS);
            float* op = F_out + (size_t)tok * DM;
#pragma unroll
            for (int i = 0; i < 8; ++i) { const int col = (i * 64 + lane) * 8;
                const f32x4 fa = *(const f32x4*)(F_final_g + col), fb = *(const f32x4*)(F_final_g + col + 4);
                f32x4 oa, ob; oa.x = acc[i][0] * rstd * fa.x; oa.y = acc[i][1] * rstd * fa.y; oa.z = acc[i][2] * rstd * fa.z; oa.w = acc[i][3] * rstd * fa.w;
                ob.x = acc[i][4] * rstd * fb.x; ob.y = acc[i][5] * rstd * fb.y; ob.z = acc[i][6] * rstd * fb.z; ob.w = acc[i][7] * rstd * fb.w;
                *(f32x4*)(op + col) = oa; *(f32x4*)(op + col + 4) = ob;
                asm volatile("" ::: "memory"); }
        }
        __syncthreads();
    }
}

__global__ void __launch_bounds__(NTHR, 2) hybrid_fwd(Args args) {
    extern __shared__ __attribute__((aligned(16))) unsigned char lds_raw[];
    Frame F;
    F.lds = (LAS unsigned char*)lds_raw;
    F.tid = threadIdx.x; F.lane = F.tid & 63; F.wave = __builtin_amdgcn_readfirstlane(F.tid >> 6); F.G = gridDim.x;
    F.in = args.in; F.out = args.out; F.ws = args.ws;
    unsigned char* ws = args.ws;
    volatile LAS unsigned* MISC = (volatile LAS unsigned*)(F.lds + MISC_OFF);
    if (F.tid < 64) MISC[F.tid] = 0u;
    __syncthreads();
    unsigned* ctl = (unsigned*)(ws + WS_CTL);
    XcdBarrier bar; bar.bar = ctl + CW_BAR + args.li * XCD_BAR_WORDS; bar.x = 0; bar.st = nullptr;
    if (MK_N_LAUNCHES != NPHASE) bar = xcd_barrier_post(ctl + CW_BAR + args.li * XCD_BAR_WORDS, MISC + 8);
    const int lo = args.ph_lo, hi = args.ph_hi;
#ifndef PH_MASK
#define PH_MASK 0x3ff
#endif
#define IN(k) (((PH_MASK >> (k)) & 1) && lo <= (k) && (k) < hi)
#define SEAM(k) do { if (IN(k) && IN((k) + 1)) xcd_barrier(bar); } while (0)
    LAS unsigned char* gl = F.lds + PH_OFF;

    if (IN(0)) { p0_prologue(F); }
    SEAM(0);
    if (IN(1)) { norm_mod_phase(F, F_x, F_norm1_g, 0 * DM, 1 * DM, F_hb); }
    SEAM(1);
    if (IN(2)) {
        pg8::Gemm gm{F_hb, F_win_t, MTOK, LDP, DM}; pg8::StaticOrder S; S.init(MTOK, LDP, F.G, (int)blockIdx.x);
        pg8::EpiBf16<0> E{F_proj, LDP, nullptr, 0, 0};
        pg8::gemm_phase<pg8::EpiBf16<0>, pg8::StaticOrder, false>(gl, gm, S, E, nullptr);
    }
    SEAM(2);
    if (IN(3)) {
#ifndef NO_SWA
        for (int it = blockIdx.x; it < 256; it += F.G) swa_item(F, it);
#endif
#ifndef NO_PREP
        for (int it = blockIdx.x; it < 512; it += F.G) gla_prep_item(F, it);
#endif
    }
    SEAM(3);
    if (IN(4)) { for (int it = blockIdx.x; it < 256; it += F.G) gla_scan_item(F, it); }
    SEAM(4);
    if (IN(5)) { gla_norm_phase(F); }
    SEAM(5);
    if (IN(6)) {
        pg8::Gemm gm{F_cat, F_wout_t, MTOK, DM, DM}; pg8::StaticOrder S; S.init(MTOK, DM, F.G, (int)blockIdx.x);
        EpiResid E{F_x, F_mod, F_x1};
        pg8::gemm_phase<EpiResid, pg8::StaticOrder, false>(gl, gm, S, E, nullptr);
    }
    SEAM(6);
    if (IN(7)) { norm_mod_phase(F, F_x1, F_norm2_g, 3 * DM, 4 * DM, F_hb); }
    SEAM(7);
    if (IN(8)) {
        pg8::Gemm gm{F_hb, F_wq_t, MTOK, 2048, DM}; pg8::StaticOrder S; S.init(MTOK, 2048, F.G, (int)blockIdx.x);
        pg8::EpiBf16<0> E{F_qb, 2048, nullptr, 0, 0};
        pg8::gemm_phase<pg8::EpiBf16<0>, pg8::StaticOrder, false>(gl, gm, S, E, nullptr);
    }
    SEAM(8);
    if (IN(9)) { peer_phase(F); }
#undef IN
#undef SEAM
}

extern "C" void kernel_launch(void* const* d_in, const int* in_sizes, int n_in, void* d_out, int out_size, void* d_ws, size_t ws_size, hipStream_t stream) {
    static int grid = 0;
    if (grid == 0) {
        if (n_in != 18 || out_size != MTOK * DM || ws_size < WS_END) { fprintf(stderr, "kernel_launch: unexpected shapes (n_in %d, out %d, ws %zu); nothing launched\n", n_in, out_size, ws_size); grid = -1; return; }
        int dev = 0, cus = 0, per_cu = 0;
        if (hipGetDevice(&dev) != hipSuccess || hipDeviceGetAttribute(&cus, hipDeviceAttributeMultiprocessorCount, dev) != hipSuccess) { grid = -1; return; }
        if (hipFuncSetAttribute((const void*)hybrid_fwd, hipFuncAttributeMaxDynamicSharedMemorySize, LDS_BYTES) != hipSuccess) { fprintf(stderr, "kernel_launch: hipFuncSetAttribute failed\n"); grid = -1; return; }
        if (hipOccupancyMaxActiveBlocksPerMultiprocessor(&per_cu, (const void*)hybrid_fwd, NTHR, LDS_BYTES) != hipSuccess || per_cu < 1) { fprintf(stderr, "kernel_launch: occupancy query says %d workgroups per CU\n", per_cu); }
        (void)hipGetLastError();
        grid = cus;
    }
    if (grid < 0) return;
    if (hipMemsetAsync((char*)d_ws + WS_CTL, 0, CTL_ZERO_BYTES, stream) != hipSuccess) { fprintf(stderr, "kernel_launch: memset failed\n"); return; }
    Args a{};
    for (int i = 0; i < 18; ++i) a.in[i] = (const float*)d_in[i];
    a.out = (float*)d_out; a.ws = (unsigned char*)d_ws;
    for (int li = 0; li < MK_N_LAUNCHES; ++li) {
        if (MK_N_LAUNCHES == NPHASE) { a.ph_lo = li; a.ph_hi = li + 1; } else { a.ph_lo = 0; a.ph_hi = NPHASE; }
        a.li = (MK_N_LAUNCHES == NPHASE) ? 0 : li;
        hipLaunchKernelGGL(hybrid_fwd, dim3(grid), dim3(NTHR), LDS_BYTES, stream, a);
        const hipError_t le = hipPeekAtLastError();
        if (le != hipSuccess) { fprintf(stderr, "kernel_launch: launch %d failed: %s\n", li, hipGetErrorName(le)); break; }
    }
}
```

```cpp
#include <hip/hip_runtime.h>
#include <cstdio>
#include <cstdint>
namespace pg8 {
#define PG8_LAS __attribute__((address_space(3)))
typedef unsigned short bf16_t;
typedef short bf16x8 __attribute__((ext_vector_type(8)));
typedef float f32x4 __attribute__((ext_vector_type(4)));
typedef unsigned u32x4 __attribute__((ext_vector_type(4)));
constexpr int BM = 256, BK = 64, HALF = 128, HTB = HALF * BK * 2  , STAGE_BYTES = 8 * HTB, NXCD = 8, WGM = 8;

__host__ __device__ __forceinline__ int lds_byte(int r, int c) { const int st = (r >> 4) * 2 + (c >> 5), rr = r & 15, cc = c & 31, ob = rr * 64 + cc * 2; return st * 1024 + (ob ^ (((ob >> 9) & 1) << 5)); }
__host__ __device__ __forceinline__ void stage_rc(int b, int& R, int& C) { const int st = b / 1024, sb = b % 1024, swz = sb ^ (((sb >> 9) & 1) << 5); R = (st >> 1) * 16 + swz / 64; C = (st & 1) * 32 + (swz % 64) / 2; }
__host__ __device__ __forceinline__ int perm32(int rho) { const int n = rho >> 4, i = rho & 15; return 8 * (i >> 2) + 4 * n + (i & 3); }

struct Unit { int pm, pn; };
struct Gemm { const bf16_t* A; const bf16_t* Bt; int M, N, K, ld; };

struct StaticOrder {
    int nM, nN, nwg, G, c;
    __host__ __device__ void init(int M, int N, int G_, int c_) { nM = M / BM; nN = N / BM; nwg = nM * nN; G = G_; c = c_; }
    __host__ __device__ bool next(int i, Unit& u) const {
        const long L = (long)i * G + c; if (L >= nwg) return false;
        int wgid = (int)L; { const int q = nwg / NXCD, r = nwg % NXCD, xcd = wgid % NXCD, off = wgid / NXCD; wgid = (xcd < r ? xcd * (q + 1) : r * (q + 1) + (xcd - r) * q) + off; }
        const int nig = WGM * nN, gid = wgid / nig, fm = gid * WGM, gsz = (nM - fm) < WGM ? (nM - fm) : WGM;
        u.pm = fm + ((wgid % nig) % gsz); u.pn = (wgid % nig) / gsz; return true;
    }
    __device__ __forceinline__ void a_ready(const Unit&) const {}
    __device__ __forceinline__ void done(const Unit&) const {}
};
__device__ __forceinline__ unsigned cvt_pk_bf16(float lo, float hi) { unsigned r; asm volatile("v_cvt_pk_bf16_f32 %0, %1, %2" : "=v"(r) : "v"(lo), "v"(hi)); return r; }
typedef float f32x2 __attribute__((ext_vector_type(2)));
__device__ __forceinline__ f32x2 gelu_pk(f32x2 v) {
    const f32x2 av = __builtin_elementwise_abs(v), d = av * 0.2316418882f + 1.0f;
    f32x2 t; t.x = __builtin_amdgcn_rcpf(d.x); t.y = __builtin_amdgcn_rcpf(d.y);
    f32x2 q = t * 0.5307027145f + (-0.7265760135f); q = q * t + 0.7107068705f; q = q * t + (-0.142248368f); q = q * t + 0.127414796f; q = q * t;
    const f32x2 s = (v * v) * (-0.72134752044f);
    f32x2 e; e.x = __builtin_amdgcn_exp2f(s.x); e.y = __builtin_amdgcn_exp2f(s.y);
    const f32x2 m = v * (q * e), r = v - m;
    f32x2 o; o.x = v.x < 0.f ? m.x : r.x; o.y = v.y < 0.f ? m.y : r.y; return o;
}

struct EpiF32 {
    static constexpr bool PERM = false, AFTER_DRAIN = false;
    float* C; int ldc; const float* bias;
    __device__ __forceinline__ void operator()(const f32x4 (&acc)[2][2][4][2], const Unit& u, int wr, int wc, int fr, int fq) const {
        const int row0 = u.pm * BM + wr * 64 + fr, col0 = u.pn * BM + wc * 32 + 4 * fq;
        f32x4 bv[2][2];
#pragma unroll
        for (int bj = 0; bj < 2; ++bj)
#pragma unroll
            for (int n = 0; n < 2; ++n) bv[bj][n] = bias ? *(const f32x4*)(bias + col0 + bj * HALF + n * 16) : (f32x4){0.f, 0.f, 0.f, 0.f};
#pragma unroll
        for (int ai = 0; ai < 2; ++ai)
#pragma unroll
            for (int m = 0; m < 4; ++m) { float* rowp = C + (size_t)(row0 + ai * HALF + m * 16) * ldc + col0;
#pragma unroll
                for (int bj = 0; bj < 2; ++bj)
#pragma unroll
                    for (int n = 0; n < 2; ++n) *(f32x4*)(rowp + bj * HALF + n * 16) = acc[ai][bj][m][n] + bv[bj][n]; }
    }
};
template <int ACT  > struct EpiBf16 {
    static constexpr bool PERM = true, AFTER_DRAIN = false;
    bf16_t* O; int ldc; const float* bias; int split_cols; size_t split_stride;
    __device__ __forceinline__ void operator()(const f32x4 (&acc)[2][2][4][2], const Unit& u, int wr, int wc, int fr, int fq) const {
        const int row0 = u.pm * BM + wr * 64 + fr; int colt = u.pn * BM; bf16_t* base = O;
        if (split_cols) { const int t = colt / split_cols; base += (size_t)t * split_stride; colt -= t * split_cols; }
        const int col0 = colt + wc * 32 + 8 * fq, bcol0 = u.pn * BM + wc * 32 + 8 * fq;
        f32x4 bv[2][2];
#pragma unroll
        for (int bj = 0; bj < 2; ++bj)
#pragma unroll
            for (int n = 0; n < 2; ++n) bv[bj][n] = bias ? *(const f32x4*)(bias + bcol0 + bj * HALF + 4 * n) : (f32x4){0.f, 0.f, 0.f, 0.f};
#pragma unroll
        for (int ai = 0; ai < 2; ++ai)
#pragma unroll
            for (int m = 0; m < 4; ++m) { bf16_t* rowp = base + (size_t)(row0 + ai * HALF + m * 16) * ldc + col0;
#pragma unroll
                for (int bj = 0; bj < 2; ++bj) { f32x4 v0 = acc[ai][bj][m][0] + bv[bj][0], v1 = acc[ai][bj][m][1] + bv[bj][1];
                    if (ACT == 1) { f32x2 a = gelu_pk((f32x2){v0[0], v0[1]}), b = gelu_pk((f32x2){v0[2], v0[3]}), c = gelu_pk((f32x2){v1[0], v1[1]}), d = gelu_pk((f32x2){v1[2], v1[3]});
                        v0 = (f32x4){a.x, a.y, b.x, b.y}; v1 = (f32x4){c.x, c.y, d.x, d.y}; }
                    if (ACT == 2) {
#pragma unroll
                        for (int j = 0; j < 4; ++j) { v0[j] = 0.5f * v0[j] * (1.0f + erff(v0[j] * 0.70710678f)); v1[j] = 0.5f * v1[j] * (1.0f + erff(v1[j] * 0.70710678f)); } }
                    u32x4 w; w.x = cvt_pk_bf16(v0[0], v0[1]); w.y = cvt_pk_bf16(v0[2], v0[3]); w.z = cvt_pk_bf16(v1[0], v1[1]); w.w = cvt_pk_bf16(v1[2], v1[3]);
                    *(u32x4*)(rowp + bj * HALF) = w; } }
    }
};
template <class Epi, class Sched, bool STAMP = false>
__device__ __forceinline__ void gemm_phase(PG8_LAS unsigned char* lds, const Gemm g, const Sched& S, const Epi& E, unsigned long long* stamps) {
    const int tid = threadIdx.x, wid = __builtin_amdgcn_readfirstlane(tid >> 6), lane = tid & 63, wr = wid >> 2, wc = wid & 3, fr = lane & 15, fq = lane >> 4;
    const int K = g.K, nt = K / BK, LD = g.ld;
    int ts_lo = 0, ts_hi = 0, nts = 0; const unsigned long long rt_entry = STAMP ? (unsigned long long)wall_clock64() : 0ull;
#define PG8_STAMP() do { if (STAMP && wid == 0 && nts < 64) { const unsigned long long _c = (unsigned long long)clock64(); \
        ts_lo = (lane == nts) ? (int)(unsigned)_c : ts_lo; ts_hi = (lane == nts) ? (int)(unsigned)(_c >> 32) : ts_hi; ++nts; } } while (0)
    PG8_STAMP();
    unsigned voffA[2], voffB[2];
#pragma unroll
    for (int i = 0; i < 2; ++i) { int R, C; stage_rc(tid * 16 + i * 8192, R, C); const int Rb = Epi::PERM ? ((R & ~31) + perm32(R & 31)) : R;
        voffA[i] = (unsigned)(R * LD + C) * 2u; voffB[i] = (unsigned)(Rb * LD + C) * 2u; }
    const size_t kstep = (size_t)(BK * 2);
    const size_t hstep = (size_t)HALF * LD * 2;
    const size_t tstep = 2 * hstep;
    const unsigned ldsw = (unsigned)wid * 1024u;
    const int aoff = lds_byte(wr * 64 + fr, fq * 8), boff = lds_byte(wc * 32 + fr, fq * 8);
#define PG8_SA(b, h) (((b) * 2 + (h)) * HTB)
#define PG8_SB(b, h) ((4 + (b) * 2 + (h)) * HTB)
#define PG8_STAGE(bufoff, gbase, voff) do { _Pragma("unroll") for (int _i = 0; _i < 2; ++_i) \
        __builtin_amdgcn_global_load_lds((const unsigned*)((const char*)(gbase) + (voff)[_i]), (PG8_LAS unsigned*)(lds + (bufoff) + ldsw + _i * 8192), 16, 0, 0); } while (0)
#define PG8_LDA(dst, b, h) do { _Pragma("unroll") for (int m = 0; m < 4; ++m) _Pragma("unroll") for (int k = 0; k < 2; ++k) dst[m][k] = *(const PG8_LAS bf16x8*)(lds + PG8_SA(b, h) + aoff + m * 2048 + k * 1024); } while (0)
#define PG8_LDB(dst, b, h) do { _Pragma("unroll") for (int n = 0; n < 2; ++n) _Pragma("unroll") for (int k = 0; k < 2; ++k) dst[n][k] = *(const PG8_LAS bf16x8*)(lds + PG8_SB(b, h) + boff + n * 2048 + k * 1024); } while (0)
#define PG8_MMA(ai, bj, At, Bt) do { __builtin_amdgcn_s_setprio(1); _Pragma("unroll") for (int m = 0; m < 4; ++m) _Pragma("unroll") for (int n = 0; n < 2; ++n) _Pragma("unroll") for (int k = 0; k < 2; ++k) \
        acc[ai][bj][m][n] = __builtin_amdgcn_mfma_f32_16x16x32_bf16(Bt[n][k], At[m][k], acc[ai][bj][m][n], 0, 0, 0); __builtin_amdgcn_s_setprio(0); } while (0)
#define PG8_WAIT_V(n) asm volatile("s_waitcnt vmcnt(" #n ")" ::: "memory")
#define PG8_WAIT_L(n) asm volatile("s_waitcnt lgkmcnt(" #n ")" ::: "memory")
#define PG8_BAR __builtin_amdgcn_s_barrier()
#define PG8_SCHED __builtin_amdgcn_sched_barrier(0)
    Unit cur, nxt; int ui = 0;
    if (!S.next(0, cur)) return;
    f32x4 acc[2][2][4][2];
#pragma unroll
    for (int a = 0; a < 2; ++a)
#pragma unroll
        for (int b = 0; b < 2; ++b)
#pragma unroll
            for (int m = 0; m < 4; ++m)
#pragma unroll
                for (int n = 0; n < 2; ++n) acc[a][b][m][n] = (f32x4){0.f, 0.f, 0.f, 0.f};
    bf16x8 At[4][2], B0[2][2], B1[2][2];
    const char* cA = (const char*)g.A + (size_t)cur.pm * tstep; const char* cB = (const char*)g.Bt + (size_t)cur.pn * tstep;
    S.a_ready(cur);
    PG8_STAGE(PG8_SB(0, 0), cB, voffB); PG8_STAGE(PG8_SA(0, 0), cA, voffA); PG8_STAGE(PG8_SB(0, 1), cB + hstep, voffB); PG8_STAGE(PG8_SA(0, 1), cA + hstep, voffA);
    if (wr == 1) PG8_BAR;
    PG8_WAIT_V(4); PG8_BAR;
    PG8_STAGE(PG8_SB(1, 0), cB + kstep, voffB); PG8_STAGE(PG8_SA(1, 0), cA + kstep, voffA); PG8_STAGE(PG8_SB(1, 1), cB + hstep + kstep, voffB);
    PG8_WAIT_V(6); PG8_BAR;
    PG8_STAMP();
    for (;;) {
        const bool has_next = S.next(ui + 1, nxt);
        const char* nA = has_next ? (const char*)g.A + (size_t)nxt.pm * tstep : cA; const char* nB = has_next ? (const char*)g.Bt + (size_t)nxt.pn * tstep : cB;
        for (int t = 0; t < nt; t += 2) {
            const bool last = (t == nt - 2);
            const char* a1 = cA + (size_t)(t + 1) * kstep;
            const char* a2 = last ? nA : cA + (size_t)(t + 2) * kstep; const char* b2 = last ? nB : cB + (size_t)(t + 2) * kstep;
            const char* a3 = a2 + kstep; const char* b3 = b2 + kstep;
            if (last && has_next) S.a_ready(nxt);
            PG8_LDB(B0, 0, 0); PG8_SCHED; PG8_LDA(At, 0, 0); PG8_STAGE(PG8_SA(1, 1), a1 + hstep, voffA);
            PG8_WAIT_L(8); PG8_BAR; PG8_WAIT_L(0); PG8_MMA(0, 0, At, B0); PG8_BAR; PG8_SCHED;
            PG8_LDB(B1, 0, 1); PG8_STAGE(PG8_SB(0, 0), b2, voffB);
            PG8_BAR; PG8_WAIT_L(0); PG8_MMA(0, 1, At, B1); PG8_BAR;
            PG8_LDA(At, 0, 1); PG8_STAGE(PG8_SA(0, 0), a2, voffA);
            PG8_BAR; PG8_WAIT_L(0); PG8_MMA(1, 0, At, B0); PG8_BAR; PG8_SCHED;
            PG8_STAGE(PG8_SB(0, 1), b2 + hstep, voffB);
            PG8_WAIT_V(6); PG8_BAR; PG8_MMA(1, 1, At, B1); PG8_BAR;
            PG8_LDB(B0, 1, 0); PG8_SCHED; PG8_LDA(At, 1, 0); PG8_STAGE(PG8_SA(0, 1), a2 + hstep, voffA);
            PG8_WAIT_L(8); PG8_BAR; PG8_WAIT_L(0); PG8_MMA(0, 0, At, B0); PG8_BAR; PG8_SCHED;
            PG8_LDB(B1, 1, 1); PG8_STAGE(PG8_SB(1, 0), b3, voffB);
            PG8_BAR; PG8_WAIT_L(0); PG8_MMA(0, 1, At, B1); PG8_BAR;
            PG8_LDA(At, 1, 1); PG8_STAGE(PG8_SA(1, 0), a3, voffA);
            PG8_BAR; PG8_WAIT_L(0); PG8_MMA(1, 0, At, B0); PG8_BAR; PG8_SCHED;
            PG8_STAGE(PG8_SB(1, 1), b3 + hstep, voffB);
            PG8_WAIT_V(6); PG8_BAR; PG8_MMA(1, 1, At, B1); PG8_BAR;
        }
        PG8_STAMP();
        if constexpr (!Epi::AFTER_DRAIN) { E(acc, cur, wr, wc, fr, fq); S.done(cur); }
        PG8_STAMP();
        if (!has_next) break;
#pragma unroll
        for (int a = 0; a < 2; ++a)
#pragma unroll
            for (int b = 0; b < 2; ++b)
#pragma unroll
                for (int m = 0; m < 4; ++m)
#pragma unroll
                    for (int n = 0; n < 2; ++n) acc[a][b][m][n] = (f32x4){0.f, 0.f, 0.f, 0.f};
        cur = nxt; cA = nA; cB = nB; ++ui;
    }
    PG8_WAIT_V(0);
    if (wr == 0) PG8_BAR;
    PG8_BAR;
    if constexpr (Epi::AFTER_DRAIN) { E.fused(acc, cur, wr, wc, fr, fq, lds, wid, lane); S.done(cur); }
    PG8_STAMP();
    if (STAMP && wid == 0) { stamps[lane] = lane < nts ? (((unsigned long long)(unsigned)ts_hi << 32) | (unsigned)ts_lo) : 0ull;
        if (lane == 62) stamps[62] = rt_entry; if (lane == 63) stamps[63] = (unsigned long long)wall_clock64(); }
#undef PG8_STAMP
#undef PG8_SA
#undef PG8_SB
#undef PG8_STAGE
#undef PG8_LDA
#undef PG8_LDB
#undef PG8_MMA
#undef PG8_WAIT_V
#undef PG8_WAIT_L
#undef PG8_BAR
#undef PG8_SCHED
}
}

#ifndef MK_N_LAUNCHES
#define MK_N_LAUNCHES 1
#endif
constexpr int NPHASE = 14;
constexpr int NWAVES = 8, NTHR = 512;
constexpr int DM = 4096, NB = 4, SEQ = 2048, MTOK = NB * SEQ;
constexpr int IN_W = 8720, LDP = 8960;
constexpr int C_AQ = 0, C_AK = 2048, C_AV = 2304, C_GQ = 2560, C_GK = 3584, C_GV = 4608, C_GOUT = 6656, C_GLOW = 8704;
constexpr int NMOD = 6 * DM;
constexpr int LDK = DM + 128;
constexpr float EPS = 1e-6f;
constexpr int NEXP = 16384;
#ifndef P2_CVT_BATCHES
#define P2_CVT_BATCHES 2
#endif
constexpr int NSL = 32, SLW = 128;
__device__ __forceinline__ int pch_of(int s) { return s >= 24 ? 32 : 128; }

constexpr size_t MiB = 1u << 20;
constexpr size_t WS_CTL = 0, CTL_ZERO_BYTES = 1 * MiB;
constexpr size_t WS_ISU = 3 * MiB, WS_ISV = 3 * MiB + 65536, WS_HINV = 3 * MiB + 131072;
constexpr size_t WS_MOD = 1 * MiB, WS_KEYS = 2 * MiB, WS_WIN = 4 * MiB, WS_WOUT = 78 * MiB, WS_WQ = 112 * MiB, WS_U = 130 * MiB, WS_V = 258 * MiB;
constexpr size_t WS_H = 386 * MiB, WS_PROJ = 454 * MiB, WS_QF = 594 * MiB, WS_KF = 610 * MiB, WS_AF = 626 * MiB, WS_DL = 630 * MiB, WS_VF = 631 * MiB;
constexpr size_t WS_O = 663 * MiB, WS_CAT = 727 * MiB, WS_X1 = 795 * MiB, WS_QB = 923 * MiB, WS_PIDX = 955 * MiB, WS_GATE = 957 * MiB, WS_WT = 961 * MiB, WS_PO = 965 * MiB, WS_VT = 1029 * MiB, WS_GP = 1033 * MiB, WS_END = 1040 * MiB;
static_assert(WS_WIN + (size_t)LDP * LDK * 2 <= WS_WOUT && WS_WOUT + (size_t)DM * LDK * 2 <= WS_WQ && WS_WQ + (size_t)2048 * LDK * 2 <= WS_U && WS_H + (size_t)MTOK * LDK * 2 <= WS_PROJ && WS_CAT + (size_t)MTOK * LDK * 2 <= WS_X1, "padded operands fit their slots");
constexpr size_t WS_PART = WS_PROJ;
static_assert(WS_PART + 256 * MiB <= WS_CAT, "partials overlay");
constexpr int CW_BAR = 4096;
constexpr int CW_TRQ = 36864;
constexpr int CW_GV = 32768;
constexpr int CW_CVT = 28672;
constexpr int CW_QU = 8192, CW_QV = 12288;

constexpr int LDS_BYTES = 151552;
constexpr int MISC_OFF = 0;
constexpr int PH_OFF = 256;

#define GAS __attribute__((address_space(1)))
#define LAS __attribute__((address_space(3)))
typedef unsigned short bf16;
typedef unsigned u32x4 __attribute__((ext_vector_type(4)));
typedef unsigned u32x2 __attribute__((ext_vector_type(2)));
typedef float f32x4 __attribute__((ext_vector_type(4)));
typedef short bf16x8 __attribute__((ext_vector_type(8)));
typedef __bf16 bf16x2_t __attribute__((ext_vector_type(2)));

__device__ __forceinline__ unsigned f2bf(float f) { unsigned u = __builtin_bit_cast(unsigned, f); return (u + 0x7fffu + ((u >> 16) & 1u)) >> 16; }
__device__ __forceinline__ unsigned pk2(float lo, float hi) { unsigned r; asm volatile("v_cvt_pk_bf16_f32 %0, %1, %2" : "=v"(r) : "v"(lo), "v"(hi)); return r; }
typedef float pk2_f32x2 __attribute__((ext_vector_type(2)));
__device__ __forceinline__ unsigned pk2s(float lo, float hi) { const pk2_f32x2 t = {lo, hi}; const bf16x2_t r = __builtin_convertvector(t, bf16x2_t); return __builtin_bit_cast(unsigned, r); }
__device__ __forceinline__ float bf2f(unsigned short b) { return __builtin_bit_cast(float, (unsigned)b << 16); }
__device__ __forceinline__ float bflo(unsigned w) { return __builtin_bit_cast(float, w << 16); }
__device__ __forceinline__ float bfhi(unsigned w) { return __builtin_bit_cast(float, w & 0xffff0000u); }
__device__ __forceinline__ float wave_sum(float v) {
#pragma unroll
    for (int o = 1; o < 64; o <<= 1) v += __shfl_xor(v, o);
    return v;
}
__device__ __forceinline__ f32x4 mfma16(bf16x8 a, bf16x8 b, f32x4 c) { return __builtin_amdgcn_mfma_f32_16x16x32_bf16(a, b, c, 0, 0, 0); }
__device__ __forceinline__ float dot2bf(unsigned a, unsigned b, float c) { return __builtin_amdgcn_fdot2_f32_bf16(__builtin_bit_cast(bf16x2_t, a), __builtin_bit_cast(bf16x2_t, b), c, false); }

#define XB_TMO      128
#define XB_XCNT(j)  (256  + 64 * (j))
#define XB_XSUB(j)  (1280 + 64 * (j))
#define XB_XGEN(j)  (2304 + 64 * (j))
#define XB_TOP      3328
#define XB_TOPGEN   3392
#define XCD_BAR_WORDS 3456
#define XB_SPIN_CAP (1u << 18)

__device__ __forceinline__ unsigned xb_ld(unsigned* p)              { return __hip_atomic_load(p, __ATOMIC_RELAXED, __HIP_MEMORY_SCOPE_AGENT); }
__device__ __forceinline__ unsigned xb_add(unsigned* p, unsigned v) { return __hip_atomic_fetch_add(p, v, __ATOMIC_RELAXED, __HIP_MEMORY_SCOPE_AGENT); }
__device__ __forceinline__ unsigned xb_xcc_id() { return (unsigned)__builtin_amdgcn_s_getreg((3 << 11) | 20) & 0xFu; }
#define XB_SPIN(cond, bar) do { unsigned _sp = 0; while (cond) { __builtin_amdgcn_s_sleep(1); \
    if ((++_sp & 255u) == 0u) { if (xb_ld(&(bar)[XB_TMO])) break; if (_sp > XB_SPIN_CAP) { atomicAdd(&(bar)[XB_TMO], 1u); break; } } } } while (0)

struct XcdBarrier {
    unsigned* bar; unsigned x;
    volatile LAS unsigned* st;
};
__device__ __forceinline__ XcdBarrier xcd_barrier_post(unsigned* bar, volatile LAS unsigned* st) {
    XcdBarrier b; b.bar = bar; b.x = xb_xcc_id(); b.st = st;
    if (threadIdx.x == 0) (void)xb_add(&bar[XB_XCNT(b.x)], 1u);
    return b;
}
__device__ __forceinline__ void xcd_barrier_complete(unsigned* bar, unsigned x, unsigned& nloc, unsigned& nx) {
    const unsigned G = gridDim.x * gridDim.y * gridDim.z;
    unsigned sum, cnt, mine, sp = 0u;
    for (;;) {
        sum = 0u; cnt = 0u; mine = 0u;
#pragma unroll
        for (unsigned j = 0; j < 16; ++j) { const unsigned c = xb_ld(&bar[XB_XCNT(j)]); sum += c; cnt += (c > 0u) ? 1u : 0u; mine = (j == x) ? c : mine; }
        if (sum == G) break;
        __builtin_amdgcn_s_sleep(1);
        if ((++sp & 255u) == 0u) { if (xb_ld(&bar[XB_TMO])) break; if (sp > XB_SPIN_CAP) { atomicAdd(&bar[XB_TMO], 1u); break; } }
    }
    nloc = mine > 0u ? mine : 1u; nx = cnt > 0u ? cnt : 1u;
}
__device__ __forceinline__ void xcd_barrier(const XcdBarrier& b) {
    asm volatile("s_waitcnt vmcnt(0)" ::: "memory");
    __syncthreads();
    if (threadIdx.x == 0) {
        unsigned* bar = b.bar;
        __builtin_amdgcn_s_waitcnt(0);
        unsigned nloc = b.st[0], nx = b.st[1];
        if (nloc == 0u) { xcd_barrier_complete(bar, b.x, nloc, nx); b.st[0] = nloc; b.st[1] = nx; }
        const unsigned old = xb_add(&bar[XB_XSUB(b.x)], 1u);
        const unsigned gen = old / nloc;
        if (old + 1u == (gen + 1u) * nloc) {
            __builtin_amdgcn_fence(__ATOMIC_RELEASE, "agent");
            asm volatile("s_waitcnt vmcnt(0)" ::: "memory");
            const unsigned og = xb_add(&bar[XB_TOP], 1u);
            const unsigned tg = og / nx;
            if (og + 1u == (tg + 1u) * nx) xb_add(&bar[XB_TOPGEN], 1u);
            else XB_SPIN(xb_ld(&bar[XB_TOPGEN]) == tg, bar);
            __builtin_amdgcn_fence(__ATOMIC_ACQUIRE, "agent");
            xb_add(&bar[XB_XGEN(b.x)], 1u);
            asm volatile("s_waitcnt vmcnt(0)" ::: "memory");
        } else {
            XB_SPIN(xb_ld(&bar[XB_XGEN(b.x)]) == gen, bar);
            __builtin_amdgcn_fence(__ATOMIC_ACQUIRE, "agent");
            asm volatile("s_waitcnt vmcnt(0)" ::: "memory");
        }
    }
    __syncthreads();
}

struct Args { const float* in[18]; float* out; unsigned char* ws; int ph_lo, ph_hi, li, pad; };
struct Frame {
    LAS unsigned char* lds;
    int tid, lane, wave, G;
    const float* const* in; float* out; unsigned char* ws;
};
#define F_x        (F.in[0])
#define F_c        (F.in[1])
#define F_w_ada    (F.in[2])
#define F_b_ada    (F.in[3])
#define F_norm1_g  (F.in[4])
#define F_norm2_g  (F.in[5])
#define F_w_in     (F.in[6])
#define F_sinks    (F.in[7])
#define F_rel_bias (F.in[8])
#define F_gk2_w    (F.in[9])
#define F_gk2_b    (F.in[10])
#define F_gla_g    (F.in[11])
#define F_w_out    (F.in[12])
#define F_peer_wq  (F.in[13])
#define F_peer_keys (F.in[14])
#define F_peer_u   (F.in[15])
#define F_peer_v   (F.in[16])
#define F_final_g  (F.in[17])
#define F_out      (F.out)
#define F_mod      ((float*)(F.ws + WS_MOD))
#define F_keysb    ((bf16*)(F.ws + WS_KEYS))
#define F_win_t    ((bf16*)(F.ws + WS_WIN))
#define F_wout_t   ((bf16*)(F.ws + WS_WOUT))
#define F_wq_t     ((bf16*)(F.ws + WS_WQ))
#define F_ub       ((bf16*)(F.ws + WS_U))
#define F_vb       ((bf16*)(F.ws + WS_V))
#define F_hb       ((bf16*)(F.ws + WS_H))
#define F_proj     ((bf16*)(F.ws + WS_PROJ))
#define F_qf       ((bf16*)(F.ws + WS_QF))
#define F_kf       ((bf16*)(F.ws + WS_KF))
#define F_af       ((bf16*)(F.ws + WS_AF))
#define F_dl       ((float*)(F.ws + WS_DL))
#define F_vf       ((bf16*)(F.ws + WS_VF))
#define F_obuf     ((bf16*)(F.ws + WS_O))
#define F_cat      ((bf16*)(F.ws + WS_CAT))
#define F_x1       ((bf16*)(F.ws + WS_X1))
#define F_qb       ((bf16*)(F.ws + WS_QB))
#define F_sk       ((unsigned*)(F.ws + WS_O))
#define F_pidx     ((unsigned short*)(F.ws + WS_PIDX))
#define F_gate     ((float*)(F.ws + WS_GATE))
#define F_wq       ((unsigned char*)(F.ws + WS_WT))
#define F_wsc      ((float*)(F.ws + WS_WT + 2 * MiB))
#define F_po       ((bf16*)(F.ws + WS_PO))
#define F_part     ((bf16*)(F.ws + WS_PART))
#define F_vt       ((bf16*)(F.ws + WS_VT))
#define F_u8       ((unsigned char*)(F.ws + WS_U))
#define F_v8       ((unsigned char*)(F.ws + WS_V))
#define F_isu      ((float*)(F.ws + WS_ISU))
#define F_isv      ((float*)(F.ws + WS_ISV))
#define F_hinv     ((float*)(F.ws + WS_HINV))
#define F_h8       ((unsigned char*)(F.ws + WS_QF))


#define LAUNDER_IDS(F) do { int t_ = (F).tid, w_ = (F).wave; asm volatile("" : "+v"(t_), "+s"(w_)); (F).tid = t_; (F).lane = t_ & 63; (F).wave = w_; } while (0)
__device__ __forceinline__ void p0_transpose_item(const float* W, int ldw, int K, int src_c0, bf16* WT, int dst_r0, int k0, LAS float* scr, int lane) {
#pragma unroll 8
    for (int i = 0; i < 32; ++i) { const int kk = 2 * i + (lane >> 5); scr[kk * 33 + (lane & 31)] = W[(size_t)(k0 + kk) * ldw + src_c0 + (lane & 31)]; }
    asm volatile("s_waitcnt lgkmcnt(0)" ::: "memory");
    const int c = lane & 7;
#pragma unroll
    for (int j = 0; j < 4; ++j) { const int n = (lane >> 3) + 8 * j; const LAS float* s = scr + (8 * c) * 33 + n;
        u32x4 o; o.x = pk2(s[0 * 33], s[1 * 33]); o.y = pk2(s[2 * 33], s[3 * 33]); o.z = pk2(s[4 * 33], s[5 * 33]); o.w = pk2(s[6 * 33], s[7 * 33]);
        *(u32x4*)(WT + (size_t)(dst_r0 + n) * K + k0 + 8 * c) = o; }
    asm volatile("s_waitcnt lgkmcnt(0)" ::: "memory");
}
__device__ __forceinline__ void cvt_rows(const float* src, bf16* dst, size_t n8, size_t i0, size_t stride) {
    for (size_t i = i0; i < n8; i += stride) { const f32x4 a = *(const f32x4*)(src + 8 * i), b = *(const f32x4*)(src + 8 * i + 4);
        u32x4 o; o.x = pk2(a.x, a.y); o.y = pk2(a.z, a.w); o.z = pk2(b.x, b.y); o.w = pk2(b.z, b.w); *(u32x4*)(dst + 8 * i) = o; }
}
__device__ __forceinline__ unsigned q8x4(f32x4 x) { const int a = (int)__builtin_rintf(x.x), b = (int)__builtin_rintf(x.y), c = (int)__builtin_rintf(x.z), d = (int)__builtin_rintf(x.w);
    return (unsigned)(a & 255) | ((unsigned)(b & 255) << 8) | ((unsigned)(c & 255) << 16) | ((unsigned)d << 24); }
template <bool I8> __device__ __forceinline__ void cvt_fp8_row(const float* src, unsigned char* dst, float* isc, int e, int lane) {
    const f32x4* sp = (const f32x4*)(src + (size_t)e * DM) + lane * 4;
    f32x4 v[16]; float am = 0.f;
#pragma unroll
    for (int m = 0; m < 4; ++m)
#pragma unroll
        for (int i = 0; i < 4; ++i) { v[m * 4 + i] = sp[m * 256 + i]; const f32x4 x = v[m * 4 + i]; am = fmaxf(am, fmaxf(fmaxf(fabsf(x.x), fabsf(x.y)), fmaxf(fabsf(x.z), fabsf(x.w)))); }
#pragma unroll
    for (int o = 1; o < 64; o <<= 1) am = fmaxf(am, __shfl_xor(am, o));
    const float top = I8 ? 127.f : 384.f;
    const float sc = am > 0.f ? top / am : 1.f;
    if (lane == 0) isc[e] = am > 0.f ? am / top : 1.f;
#pragma unroll
    for (int m = 0; m < 4; ++m) { u32x4 o; unsigned ow[4];
#pragma unroll
        for (int i = 0; i < 4; ++i) { const f32x4 x = v[m * 4 + i] * sc;
            if (I8) ow[i] = q8x4(x);
            else { int pk = 0; pk = __builtin_amdgcn_cvt_pk_fp8_f32(x.x, x.y, pk, false); pk = __builtin_amdgcn_cvt_pk_fp8_f32(x.z, x.w, pk, true); ow[i] = (unsigned)pk; } }
        o.x = ow[0]; o.y = ow[1]; o.z = ow[2]; o.w = ow[3];
        *(u32x4*)(dst + ((size_t)(8 * m + (lane >> 3)) * NEXP + e) * SLW + (lane & 7) * 16) = o; }
}
__device__ __forceinline__ void cvt_u4_row(const float* src, unsigned char* dst, float* isc, int e, int lane) {
    const f32x4* sp = (const f32x4*)(src + (size_t)e * DM) + lane * 4;
    f32x4 v[16]; float am = 0.f;
#pragma unroll
    for (int m = 0; m < 4; ++m)
#pragma unroll
        for (int i = 0; i < 4; ++i) { v[m * 4 + i] = sp[m * 256 + i]; const f32x4 x = v[m * 4 + i]; am = fmaxf(am, fmaxf(fmaxf(fabsf(x.x), fabsf(x.y)), fmaxf(fabsf(x.z), fabsf(x.w)))); }
#pragma unroll
    for (int o = 1; o < 64; o <<= 1) am = fmaxf(am, __shfl_xor(am, o));
    const float sc = am > 0.f ? 7.5f / am : 1.f;
    if (lane == 0) isc[e] = am > 0.f ? am * (1.f / 7.5f) : 1.f;
#pragma unroll
    for (int m = 0; m < 4; ++m) { unsigned nb[16];
#pragma unroll
        for (int i = 0; i < 4; ++i) { const f32x4 x = v[m * 4 + i] * sc + 8.f;
            const unsigned n0 = (unsigned)x.x, n1 = (unsigned)x.y, n2 = (unsigned)x.z, n3 = (unsigned)x.w;
            nb[4 * i + 0] = n0 ^ 8u; nb[4 * i + 1] = n1 ^ 8u; nb[4 * i + 2] = n2 ^ 8u; nb[4 * i + 3] = n3 ^ 8u; }
        u32x2 o; o.x = 0u; o.y = 0u;
#pragma unroll
        for (int j = 0; j < 8; ++j) o.x |= nb[j] << (4 * j);
#pragma unroll
        for (int j = 0; j < 8; ++j) o.y |= nb[8 + j] << (4 * j);
        *(u32x2*)(dst + ((size_t)(4 * m + (lane >> 4)) * NEXP + e) * 128 + 8 * (lane & 15)) = o; }
}
__device__ __forceinline__ void cvt_pull(Frame& F, unsigned* head, int max_batches) {
    for (int nb = 0; nb < max_batches; ++nb) {
        unsigned h = 0u; if (F.lane == 0) h = __hip_atomic_fetch_add(head, 1u, __ATOMIC_RELAXED, __HIP_MEMORY_SCOPE_AGENT);
        h = (unsigned)__builtin_amdgcn_readfirstlane((int)h);
        if (h >= 4096u) break;
#pragma unroll 1
        for (int r = 0; r < 8; ++r) { const int row = (int)h * 8 + r;
            if (row < NEXP) cvt_u4_row(F_peer_u, F_u8, F_isu, row, F.lane); else cvt_fp8_row<true>(F_peer_v, F_v8, F_isv, row - NEXP, F.lane); }
    }
}
__device__ __forceinline__ void p0_prologue(Frame& F) {
    const int tid = F.tid, lane = F.lane, wave = F.wave;
    if (F.G == 256) {
        LAS float* sc = (LAS float*)(F.lds + PH_OFF);
        volatile LAS int* qw = (volatile LAS int*)(F.lds + MISC_OFF + 64);
        const int cg = blockIdx.x & 15, kq = blockIdx.x >> 4;
        for (int i = tid; i < 4 * 256; i += NTHR) { const float v = F_c[(i >> 8) * DM + 256 * kq + (i & 255)]; sc[i] = v / (1.f + __expf(-v)); }
        __syncthreads();
        float* gp = (float*)(F.ws + WS_GP);
        if (tid < 384) {
            f32x4 acc[4];
#pragma unroll
            for (int b = 0; b < 4; ++b) acc[b] = (f32x4){0.f, 0.f, 0.f, 0.f};
            const float* wp = F_w_ada + (size_t)(256 * kq) * NMOD + 1536 * cg + 4 * tid;
#pragma unroll 8
            for (int k = 0; k < 256; ++k) { const f32x4 w = *(const f32x4*)wp; wp += NMOD;
#pragma unroll
                for (int b = 0; b < 4; ++b) acc[b] += w * sc[b * 256 + k]; }
#pragma unroll
            for (int b = 0; b < 4; ++b) *(f32x4*)(gp + ((size_t)kq * 4 + b) * NMOD + 1536 * cg + 4 * tid) = acc[b];
        }
        asm volatile("s_waitcnt vmcnt(0)" ::: "memory");
        __syncthreads();
        if (tid == 0) { __builtin_amdgcn_fence(__ATOMIC_RELEASE, "agent"); asm volatile("s_waitcnt vmcnt(0)" ::: "memory");
            const unsigned old = __hip_atomic_fetch_add((unsigned*)(F.ws + WS_CTL) + CW_GV + 64 * cg, 1u, __ATOMIC_RELAXED, __HIP_MEMORY_SCOPE_AGENT);
            if (old == 15u) { __builtin_amdgcn_fence(__ATOMIC_ACQUIRE, "agent"); asm volatile("s_waitcnt vmcnt(0)" ::: "memory"); }
            qw[0] = (int)old; }
        __syncthreads();
        if (qw[0] == 15) {
            for (int o = tid; o < 4 * 384; o += NTHR) { const int b = o / 384, c4 = o % 384; const size_t col = (size_t)1536 * cg + 4 * c4;
                f32x4 sum = *(const f32x4*)(F_b_ada + col);
#pragma unroll 4
                for (int k2 = 0; k2 < 16; ++k2) sum += *(const f32x4*)(gp + ((size_t)k2 * 4 + b) * NMOD + col);
                *(f32x4*)(F_mod + (size_t)b * NMOD + col) = sum; }
        }
        __syncthreads();
    } else
    {
        LAS float* sc = (LAS float*)(F.lds + PH_OFF);
        LAS float* red = sc + 4 * DM;
        for (int i = tid; i < 4 * DM; i += NTHR) { const float v = F_c[i]; sc[i] = v / (1.f + __expf(-v)); }
        __syncthreads();
        for (int slab = blockIdx.x; slab < NMOD / 96; slab += F.G) {
            const int cg = tid % 24, kg = tid / 24;
            if (kg < 21) {
                f32x4 acc[4];
#pragma unroll
                for (int b = 0; b < 4; ++b) acc[b] = (f32x4){0.f, 0.f, 0.f, 0.f};
                const float* wp = F_w_ada + (size_t)kg * NMOD + slab * 96 + cg * 4;
#pragma unroll 4
                for (int k = kg; k < DM; k += 21) { const f32x4 w = *(const f32x4*)wp; wp += (size_t)21 * NMOD;
#pragma unroll
                    for (int b = 0; b < 4; ++b) acc[b] += w * sc[b * DM + k]; }
#pragma unroll
                for (int b = 0; b < 4; ++b) *(LAS f32x4*)(red + (kg * 4 + b) * 96 + cg * 4) = acc[b];
            }
            __syncthreads();
            if (tid < 384) { const int b = tid / 96, col = tid % 96; float s = F_b_ada[slab * 96 + col];
                for (int kg2 = 0; kg2 < 21; ++kg2) s += red[(kg2 * 4 + b) * 96 + col];
                F_mod[b * NMOD + slab * 96 + col] = s; }
            __syncthreads();
        }
    }
    {
        LAS float* scr = (LAS float*)(F.lds + PH_OFF + wave * 8448);
        const int gw = blockIdx.x * NWAVES + wave, NGW = F.G * NWAVES;
        constexpr int I_IN = 64 * 272;
        for (int it = gw; it < I_IN; it += NGW) { const int kb = it / 272, nb = it % 272, r0 = nb * 32; p0_transpose_item(F_w_in, IN_W, LDK, r0 < 6656 ? r0 : r0 + 16, F_win_t, r0, kb * 64, scr, lane); }
        const size_t gt = (size_t)blockIdx.x * NTHR + tid, NT = (size_t)F.G * NTHR;
        for (size_t i = gt; i < (size_t)256 * DM / 8; i += NT) { const int row = (int)(i / (DM / 8)), kc = (int)(i % (DM / 8)) * 8;
            u32x4 o = {0u, 0u, 0u, 0u};
            if (row < 16) { float v[8];
#pragma unroll
                for (int j = 0; j < 8; ++j) v[j] = F_w_in[(size_t)(kc + j) * IN_W + 6656 + row];
                o.x = pk2(v[0], v[1]); o.y = pk2(v[2], v[3]); o.z = pk2(v[4], v[5]); o.w = pk2(v[6], v[7]); }
            *(u32x4*)(F_win_t + (size_t)(8704 + row) * LDK + kc) = o; }
    }
}
__device__ __forceinline__ void swa_block_item(Frame& F, int item);
__device__ __forceinline__ bf16x8 ld8_bf16(const float* p) { const f32x4 a = *(const f32x4*)p, b = *(const f32x4*)(p + 4); u32x4 o; o.x = pk2(a.x, a.y); o.y = pk2(a.z, a.w); o.z = pk2(b.x, b.y); o.w = pk2(b.z, b.w); return __builtin_bit_cast(bf16x8, o); }
__device__ __forceinline__ void fold_keys_task(Frame& F, int ft) {
    const int lane = F.lane, g = lane >> 4, n = lane & 15, hp = ft >> 6, D0 = (ft & 63) * 64;
    bf16x8 af[4][4];
#pragma unroll
    for (int dt = 0; dt < 4; ++dt)
#pragma unroll
        for (int ks = 0; ks < 4; ++ks) af[dt][ks] = ld8_bf16(F_peer_wq + (size_t)(D0 + 16 * dt + n) * 2048 + hp * 128 + 32 * ks + 8 * g);
#pragma unroll 1
    for (int kt0 = 0; kt0 < 8; kt0 += 4) {
        bf16x8 bfr[4][4];
#pragma unroll
        for (int kq = 0; kq < 4; ++kq)
#pragma unroll
            for (int ks = 0; ks < 4; ++ks) bfr[kq][ks] = ld8_bf16(F_peer_keys + ((size_t)hp * 128 + 16 * (kt0 + kq) + n) * 128 + 32 * ks + 8 * g);
#pragma unroll
        for (int kq = 0; kq < 4; ++kq)
#pragma unroll
            for (int dt = 0; dt < 4; ++dt) { f32x4 acc = {0.f, 0.f, 0.f, 0.f};
#pragma unroll
                for (int ks = 0; ks < 4; ++ks) acc = mfma16(af[dt][ks], bfr[kq][ks], acc);
                u32x2 o; o.x = pk2s(acc[0], acc[1]); o.y = pk2s(acc[2], acc[3]);
                *(u32x2*)(F_wq_t + (size_t)(hp * 128 + 16 * (kt0 + kq) + n) * LDK + D0 + 16 * dt + 4 * g) = o; }
    }
}
__device__ __forceinline__ void trans_pull(Frame& F, LAS float* scr) {
    constexpr int I_OUT = 64 * 128, I_Q = 64 * 64, NBATCH = (I_OUT + I_Q) / 4;
    unsigned* head = (unsigned*)(F.ws + WS_CTL) + CW_TRQ;
    for (;;) {
        unsigned hq = 0u; if (F.lane == 0) hq = __hip_atomic_fetch_add(head, 1u, __ATOMIC_RELAXED, __HIP_MEMORY_SCOPE_AGENT);
        hq = (unsigned)__builtin_amdgcn_readfirstlane((int)hq);
        if (hq >= (unsigned)NBATCH) break;
        if ((int)hq >= I_OUT / 4) { fold_keys_task(F, (int)hq - I_OUT / 4); continue; }
#pragma unroll 1
        for (int j = 0; j < 4; ++j) { const int it = (int)hq * 4 + j; const int kb = it / 128, nb = it % 128; p0_transpose_item(F_w_out, DM, LDK, nb * 32, F_wout_t, nb * 32, kb * 64, scr, F.lane); }
    }
}
__device__ __forceinline__ void p4_side(Frame& F, int sb, int nsb) {
    for (int item = sb; item < NB * 2 * 16; item += nsb) swa_block_item(F, item);
    LAUNDER_IDS(F);
    trans_pull(F, (LAS float*)(F.lds + PH_OFF + F.wave * 8448));
    cvt_pull(F, (unsigned*)(F.ws + WS_CTL) + CW_CVT, 1 << 20);
}

template <bool IN16, bool Q8> __device__ __forceinline__ void norm_mod_phase(Frame& F, const void* xin, const float* g, int shift_off, int scale_off, bf16* outp) {
    const int gw = blockIdx.x * NWAVES + F.wave, NGW = F.G * NWAVES, lane = F.lane;
    for (int row = gw; row < MTOK; row += NGW) {
        const int b = row / SEQ;
        f32x4 v[16]; float ss = 0.f;
        if (IN16) { const u32x2* xr = (const u32x2*)((const bf16*)xin + (size_t)row * DM) + lane;
#pragma unroll
            for (int j = 0; j < 16; ++j) { const u32x2 t = xr[64 * j]; v[j] = (f32x4){bflo(t.x), bfhi(t.x), bflo(t.y), bfhi(t.y)}; }
        } else { const f32x4* xr = (const f32x4*)((const float*)xin + (size_t)row * DM) + lane;
#pragma unroll
            for (int j = 0; j < 16; ++j) v[j] = xr[64 * j]; }
#pragma unroll
        for (int j = 0; j < 16; ++j) ss += (v[j].x * v[j].x + v[j].y * v[j].y) + (v[j].z * v[j].z + v[j].w * v[j].w);
        const float rstd = rsqrtf(wave_sum(ss) * (1.f / DM) + EPS);
        const float* mb = F_mod + (size_t)b * NMOD;
        u32x2* op = (u32x2*)(outp + (size_t)row * LDK) + lane;
        float am = 0.f;
#pragma unroll
        for (int j = 0; j < 16; ++j) { const int col = (lane + 64 * j) * 4;
            const f32x4 gv = *(const f32x4*)(g + col), sc = *(const f32x4*)(mb + scale_off + col), sh = *(const f32x4*)(mb + shift_off + col);
            const f32x4 y = (v[j] * rstd) * gv * (sc + 1.f) + sh;
            u32x2 o; o.x = pk2(y.x, y.y); o.y = pk2(y.z, y.w); op[64 * j] = o;
            if (Q8) { v[j] = y; am = fmaxf(am, fmaxf(fmaxf(fabsf(y.x), fabsf(y.y)), fmaxf(fabsf(y.z), fabsf(y.w)))); } }
        if (Q8) {
#pragma unroll
            for (int o2 = 1; o2 < 64; o2 <<= 1) am = fmaxf(am, __shfl_xor(am, o2));
            const float S = am > 0.f ? 119.f / am : 1.f;
            if (lane == 0) F_hinv[row] = am > 0.f ? am * (1.f / 119.f) : 1.f;
            unsigned* hph = (unsigned*)(F_h8 + (size_t)row * 2048) + (lane >> 1);
            unsigned* hpl = (unsigned*)(F_h8 + (size_t)MTOK * 2048 + (size_t)row * 2048) + (lane >> 1);
#pragma unroll
            for (int j = 0; j < 16; ++j) { const unsigned x = q8x4(v[j] * S);
                const unsigned t2 = (x ^ 0x80808080u) + 0x08080808u;
                const unsigned HI = ((t2 >> 4) & 0x0F0F0F0Fu) ^ 0x08080808u, LO = (t2 & 0x0F0F0F0Fu) ^ 0x08080808u;
                const unsigned yh = HI | (HI >> 4), yl = LO | (LO >> 4);
                const unsigned ch = __builtin_amdgcn_perm(yh, yh, 0x00000200u) & 0xFFFFu, cl = __builtin_amdgcn_perm(yl, yl, 0x00000200u) & 0xFFFFu;
                const unsigned ph = (unsigned)__builtin_amdgcn_update_dpp(0, (int)ch, 0xB1, 0xf, 0xf, true), pl = (unsigned)__builtin_amdgcn_update_dpp(0, (int)cl, 0xB1, 0xf, 0xf, true);
                if (!(lane & 1)) { hph[32 * j] = ch | (ph << 16); hpl[32 * j] = cl | (pl << 16); } }
        }
    }
}

__device__ __forceinline__ int t5_bucket(int d) {
    if (d < 16) return d;
    const int v = 16 + (int)(__log2f((float)d * (1.f / 16.f)) * (16.f / 3.f));
    return v < 31 ? v : 31;
}
constexpr int KS_LDK = 136, VT_LD = 296;
__device__ __forceinline__ void swa_block_item(Frame& F, int item) {
    const int tid = F.tid, lane = F.lane, w = F.wave, g = lane >> 4, r = lane & 15;
    const int n = item & 15, kvh = (item >> 4) & 1, b = item >> 5;
    LAS unsigned short* Ks = (LAS unsigned short*)(F.lds + PH_OFF);
    LAS unsigned short* Vt = Ks + 256 * KS_LDK;
    LAS float* btab = (LAS float*)(Vt + 128 * VT_LD);
    const int tok0 = b * SEQ + n * 128, tokmin = b * SEQ;
    __syncthreads();
    {
        const int kr = tid >> 4, kc = tid & 15;
        LAS unsigned char* kl = (LAS unsigned char*)Ks + kr * (KS_LDK * 2) + 16 * kc;
        const int r0 = (n == 0) ? tokmin + kr : tok0 - 128 + kr;
        const unsigned char* kg0 = (const unsigned char*)(F_proj + (size_t)r0 * LDP + C_AK + kvh * 128 + 8 * kc);
        const unsigned char* kg1 = (const unsigned char*)(F_proj + (size_t)(tok0 + kr) * LDP + C_AK + kvh * 128 + 8 * kc);
        u32x4 kv[8];
#pragma unroll
        for (int j = 0; j < 4; ++j) { kv[j] = *(const u32x4*)(kg0 + (size_t)j * (32 * LDP * 2)); kv[4 + j] = *(const u32x4*)(kg1 + (size_t)j * (32 * LDP * 2)); }
#pragma unroll
        for (int j = 0; j < 8; ++j) *(LAS u32x4*)(kl + j * (32 * KS_LDK * 2)) = kv[j];
        const int vr = tid >> 5, vc = tid & 31;
        LAS unsigned char* vl = (LAS unsigned char*)Vt + vr * (VT_LD * 2) + 16 * vc;
        const int tcol = (n == 0 && vc < 16) ? tokmin + 8 * vc : tok0 - 128 + 8 * vc;
        const unsigned char* vg = (const unsigned char*)(F_vt + (size_t)(kvh * 128 + vr) * MTOK + tcol);
#pragma unroll
        for (int j = 0; j < 8; ++j) kv[j] = *(const u32x4*)(vg + (size_t)j * (16 * MTOK * 2));
#pragma unroll
        for (int j = 0; j < 8; ++j) *(LAS u32x4*)(vl + j * (16 * VT_LD * 2)) = kv[j];
    }
    for (int idx = tid; idx < 128 * 5; idx += NTHR) *(LAS u32x4*)(Vt + (idx / 5) * VT_LD + 256 + 8 * (idx % 5)) = (u32x4){0u, 0u, 0u, 0u};
    for (int idx = tid; idx < 8 * 128; idx += NTHR) btab[idx] = F_rel_bias[t5_bucket(idx & 127) * 16 + kvh * 8 + (idx >> 7)];
    __syncthreads();
    constexpr float SCALE = 0.08838834764831845f;
    const int lb = 4 * g + 16 * w - (n == 0 ? 128 : 0), lrel = 4 * g - r;
#pragma unroll 1
    for (int hh = 0; hh < 8; ++hh) {
        const int h = kvh * 8 + hh;
        bf16x8 qfr[4];
        { const bf16* qp = F_proj + (size_t)(tok0 + 16 * w + r) * LDP + C_AQ + h * 128 + 8 * g;
#pragma unroll
          for (int ks = 0; ks < 4; ++ks) qfr[ks] = *(const bf16x8*)(qp + 32 * ks); }
        float sc[9][4];
#pragma unroll
        for (int t = 0; t < 9; ++t) {
            const LAS unsigned short* kp = Ks + (16 * (w + t) + r) * KS_LDK + 8 * g;
            f32x4 acc0 = {0.f, 0.f, 0.f, 0.f};
#pragma unroll
            for (int ks = 0; ks < 4; ++ks) acc0 = mfma16(*(const LAS bf16x8*)(kp + 32 * ks), qfr[ks], acc0);
#pragma unroll
            for (int reg = 0; reg < 4; ++reg) { const int rel = lrel + 16 * t + reg;
                const bool ok = (rel > 0) && (rel <= 128) && (lb + 16 * t + reg >= 0);
                sc[t][reg] = ok ? acc0[reg] * SCALE + btab[hh * 128 + ((128 - rel) & 127)] : -1e30f; }
        }
        const float sink = F_sinks[h];
        float m = sink;
#pragma unroll
        for (int t = 0; t < 9; ++t)
#pragma unroll
            for (int reg = 0; reg < 4; ++reg) m = fmaxf(m, sc[t][reg]);
        m = fmaxf(m, __shfl_xor(m, 16)); m = fmaxf(m, __shfl_xor(m, 32));
        float sum = 0.f;
#pragma unroll
        for (int t = 0; t < 9; ++t)
#pragma unroll
            for (int reg = 0; reg < 4; ++reg) { sc[t][reg] = __expf(sc[t][reg] - m); sum += sc[t][reg]; }
        sum += __shfl_xor(sum, 16); sum += __shfl_xor(sum, 32);
        const float inv = 1.f / (sum + __expf(sink - m));
        f32x4 o[8];
#pragma unroll
        for (int dt = 0; dt < 8; ++dt) o[dt] = (f32x4){0.f, 0.f, 0.f, 0.f};
#pragma unroll
        for (int s5 = 0; s5 < 5; ++s5) {
            u32x4 pw; pw.x = pk2(sc[2 * s5][0], sc[2 * s5][1]); pw.y = pk2(sc[2 * s5][2], sc[2 * s5][3]);
            if (2 * s5 + 1 < 9) { pw.z = pk2(sc[(2 * s5 + 1) % 9][0], sc[(2 * s5 + 1) % 9][1]); pw.w = pk2(sc[(2 * s5 + 1) % 9][2], sc[(2 * s5 + 1) % 9][3]); } else { pw.z = 0u; pw.w = 0u; }
            const bf16x8 pf = __builtin_bit_cast(bf16x8, pw);
            const LAS unsigned short* vp0 = Vt + r * VT_LD + 16 * w + 32 * s5 + 4 * g;
#pragma unroll
            for (int dt = 0; dt < 8; ++dt) { const LAS unsigned short* vp = vp0 + (16 * dt) * VT_LD;
                const u32x2 lo = *(const LAS u32x2*)vp, hi = *(const LAS u32x2*)(vp + 16);
                u32x4 va; va.x = lo.x; va.y = lo.y; va.z = hi.x; va.w = hi.y;
                o[dt] = mfma16(__builtin_bit_cast(bf16x8, va), pf, o[dt]); }
        }
        bf16* op = F_cat + (size_t)(tok0 + 16 * w + r) * LDK + h * 128 + 4 * g;
#pragma unroll
        for (int dt = 0; dt < 8; ++dt) { u32x2 ov; ov.x = pk2(o[dt][0] * inv, o[dt][1] * inv); ov.y = pk2(o[dt][2] * inv, o[dt][3] * inv); *(u32x2*)(op + 16 * dt) = ov; }
    }
    __syncthreads();
}

constexpr int QD_LD = 264, VS_LD = 520;
__device__ __forceinline__ void gla_prep_item(Frame& F, int item) {
    const int tid = F.tid, lane = F.lane, w = F.wave, g = lane >> 4, r = lane & 15;
    const int n = item & 31, h = (item >> 5) & 3, b = item >> 7;
    const int tok0 = b * SEQ + n * 64;
    LAS float* glw = (LAS float*)(F.lds + PH_OFF);
    LAS float* bc = glw + 1024;
    LAS unsigned* pk = (LAS unsigned*)bc;
    LAS unsigned short* qd = (LAS unsigned short*)(bc + 64 * 256);
    LAS unsigned short* ki = qd + 64 * QD_LD;
    LAS unsigned short* vs = qd;
    for (int idx = tid; idx < 1024; idx += NTHR) glw[idx] = bf2f(F_proj[(size_t)(tok0 + (idx >> 4)) * LDP + C_GLOW + (idx & 15)]);
    __syncthreads();
    const int d = tid & 255, half = tid >> 8;
    {
        float wv[16];
#pragma unroll
        for (int q = 0; q < 16; ++q) wv[q] = F_gk2_w[q * 1024 + h * 256 + d];
        const float bias = F_gk2_b[h * 256 + d];
        float run = 0.f;
        for (int tt = 0; tt < 32; ++tt) { const int t = half * 32 + tt; float z = bias;
#pragma unroll
            for (int q = 0; q < 16; ++q) z += glw[t * 16 + q] * wv[q];
            const float ls = fminf(z, 0.f) - log1pf(__expf(-fabsf(z)));
            run += ls * (1.f / 16.f); bc[t * 256 + d] = run; }
    }
    __syncthreads();
    {
        const float off = half ? bc[31 * 256 + d] : 0.f;
        const float blast = bc[63 * 256 + d] + bc[31 * 256 + d];
        __syncthreads();
        const bf16* qg = F_proj + (size_t)tok0 * LDP + C_GQ + h * 256 + d;
#pragma unroll 4
        for (int tt = 0; tt < 32; ++tt) { const int t = half * 32 + tt; const float bt = bc[t * 256 + d] + off;
            const float q = bf2f(qg[(size_t)t * LDP]), k = bf2f(qg[(size_t)t * LDP + (C_GK - C_GQ)]);
            const float qdv = q * (1.f / 16.f) * __expf(bt), kiv = k * __expf(-bt), kdv = k * __expf(blast - bt);
            const unsigned qb16 = f2bf(qdv);
            qd[t * QD_LD + d] = (unsigned short)qb16; ki[t * QD_LD + d] = (unsigned short)f2bf(kiv);
            pk[t * 256 + d] = qb16 | (f2bf(kdv) << 16); }
        if (half == 0) F_dl[(size_t)item * 256 + d] = __expf(blast);
    }
    __syncthreads();
    {
        bf16* qfp = F_qf + (size_t)item * 16384; bf16* kfp = F_kf + (size_t)item * 16384;
#pragma unroll
        for (int j4 = 0; j4 < 4; ++j4) { const int pc = tid + 512 * j4, fl = pc & 63, fr = pc >> 6, fg = fl >> 4, fi = fl & 15;
            { const int T = fr >> 2, tt = fr & 3, t = 16 * tt + fi;
              const u32x2 lo = *(const LAS u32x2*)(qd + t * QD_LD + 32 * T + 4 * fg), hi = *(const LAS u32x2*)(qd + t * QD_LD + 32 * T + 16 + 4 * fg);
              u32x4 o; o.x = lo.x; o.y = lo.y; o.z = hi.x; o.w = hi.y; *(u32x4*)(qfp + (size_t)pc * 8) = o; }
            { const int dkt = fr >> 1, ks = fr & 1;
              const LAS unsigned* kp = pk + (32 * ks + 8 * fg) * 256 + 16 * dkt + fi;
              u32x4 o; o.x = (kp[0] >> 16) | (kp[256] & 0xffff0000u); o.y = (kp[512] >> 16) | (kp[768] & 0xffff0000u); o.z = (kp[1024] >> 16) | (kp[1280] & 0xffff0000u); o.w = (kp[1536] >> 16) | (kp[1792] & 0xffff0000u);
              *(u32x4*)(kfp + (size_t)pc * 8) = o; } }
        bf16* afp = F_af + (size_t)item * 4096;
        for (int tile = w; tile < 16; tile += 8) { const int ti = tile >> 2, tj = tile & 3;
            f32x4 acc = {0.f, 0.f, 0.f, 0.f};
            if (tj <= ti) {
#pragma unroll
                for (int ks = 0; ks < 8; ++ks) acc = mfma16(*(const LAS bf16x8*)(qd + (16 * ti + r) * QD_LD + 32 * ks + 8 * g), *(const LAS bf16x8*)(ki + (16 * tj + r) * QD_LD + 32 * ks + 8 * g), acc); }
#pragma unroll
            for (int reg = 0; reg < 4; ++reg) { const int row = 16 * ti + 4 * g + reg, col = 16 * tj + r;
                const float val = (tj <= ti && row >= col) ? acc[reg] : 0.f;
                afp[(((row >> 4) * 2 + (col >> 5)) * 64 + ((col & 31) >> 3) * 16 + (row & 15)) * 8 + (col & 7)] = (unsigned short)f2bf(val); }
        }
    }
    __syncthreads();
    {
#pragma unroll
        for (int j8 = 0; j8 < 8; ++j8) { const int idx = tid + 512 * j8, t = idx >> 6, c = idx & 63;
            *(LAS u32x4*)(vs + t * VS_LD + 8 * c) = *(const u32x4*)(F_proj + (size_t)(tok0 + t) * LDP + C_GV + h * 512 + 8 * c); }
        __syncthreads();
        bf16* vfp = F_vf + (size_t)item * 32768;
#pragma unroll
        for (int j8 = 0; j8 < 8; ++j8) { const int pc = tid + 512 * j8, fl = pc & 63, fr = pc >> 6, fg = fl >> 4, fi = fl & 15, dvt = fr >> 1, ks = fr & 1;
            const LAS unsigned short* vp = vs + (32 * ks + 8 * fg) * VS_LD + 16 * dvt + fi;
            u32x4 o; o.x = (unsigned)vp[0] | ((unsigned)vp[VS_LD] << 16); o.y = (unsigned)vp[2 * VS_LD] | ((unsigned)vp[3 * VS_LD] << 16); o.z = (unsigned)vp[4 * VS_LD] | ((unsigned)vp[5 * VS_LD] << 16); o.w = (unsigned)vp[6 * VS_LD] | ((unsigned)vp[7 * VS_LD] << 16);
            *(u32x4*)(vfp + (size_t)pc * 8) = o; }
    }
    __syncthreads();
}

constexpr int SCA_BYTES = 57344, SCB_BYTES = 33792;
#define SC_BAR() asm volatile("s_waitcnt lgkmcnt(0)\n\ts_barrier" ::: "memory")
__device__ __forceinline__ void gla_scan_lds(Frame& F, int item) {
    const int tid = F.tid, lane = F.lane, w = F.wave, g = lane >> 4, r = lane & 15;
    const int bh = item >> 2, q4 = item & 3, b = bh >> 2, h = bh & 3;
    LAS unsigned char* bufA = F.lds + PH_OFF;
    LAS unsigned char* bufB = bufA + SCA_BYTES;
    const size_t ch0 = (size_t)bh * 32;
#define SCAN_LOAD_A(ch) do { const u32x4* q_ = (const u32x4*)(F_qf + (size_t)(ch) * 16384) + lt; const u32x4* a_ = (const u32x4*)(F_af + (size_t)(ch) * 4096) + lt; const u32x4* v_ = (const u32x4*)(F_vf + (size_t)(ch) * 32768 + q4 * 8192) + lt; \
        _Pragma("unroll") for (int j = 0; j < 8; ++j) ra[j] = q_[256 * j]; ra[8] = a_[0]; ra[9] = a_[256]; _Pragma("unroll") for (int j = 0; j < 4; ++j) ra[10 + j] = v_[256 * j]; } while (0)
#define SCAN_LOAD_B(ch) do { const u32x4* k_ = (const u32x4*)(F_kf + (size_t)(ch) * 16384) + lt; _Pragma("unroll") for (int j = 0; j < 8; ++j) rb[j] = k_[256 * j]; if (lt < 64) rb[8] = ((const u32x4*)(F_dl + (size_t)(ch) * 256))[lt]; } while (0)
#define SCAN_PUT_A() do { _Pragma("unroll") for (int j = 0; j < 14; ++j) *(LAS u32x4*)(bufA + (lt + 256 * j) * 16) = ra[j]; } while (0)
#define SCAN_PUT_B() do { _Pragma("unroll") for (int j = 0; j < 8; ++j) *(LAS u32x4*)(bufB + (lt + 256 * j) * 16) = rb[j]; if (lt < 64) *(LAS u32x4*)(bufB + (lt + 2048) * 16) = rb[8]; } while (0)
    if (w >= 4) {
        const int lt = tid - 256;
        u32x4 ra[14], rb[9];
        SCAN_LOAD_A(ch0); SCAN_LOAD_B(ch0); SCAN_PUT_A();
        SC_BAR();
#pragma unroll 1
        for (int n = 0; n < 32; ++n) {
            const size_t chn = ch0 + (n < 31 ? n + 1 : 31);
            SCAN_PUT_B(); SCAN_LOAD_A(chn);
            SC_BAR();
            SCAN_PUT_A(); SCAN_LOAD_B(chn);
            SC_BAR();
        }
    } else {
        f32x4 S[16][2];
#pragma unroll
        for (int i = 0; i < 16; ++i) { S[i][0] = (f32x4){0.f, 0.f, 0.f, 0.f}; S[i][1] = (f32x4){0.f, 0.f, 0.f, 0.f}; }
        SC_BAR();
#pragma unroll 1
        for (int n = 0; n < 32; ++n) {
            const LAS bf16x8* qfp = (const LAS bf16x8*)bufA + lane;
            const LAS bf16x8* afp = (const LAS bf16x8*)(bufA + 32768) + lane;
            const LAS bf16x8* vfp = (const LAS bf16x8*)(bufA + 40960) + (w * 4) * 64 + lane;
            const bf16x8 vb00 = vfp[0], vb01 = vfp[64], vb10 = vfp[128], vb11 = vfp[192];
            f32x4 o[4][2];
#pragma unroll
            for (int tt = 0; tt < 4; ++tt) { o[tt][0] = (f32x4){0.f, 0.f, 0.f, 0.f}; o[tt][1] = (f32x4){0.f, 0.f, 0.f, 0.f}; }
#pragma unroll
            for (int T = 0; T < 8; ++T) {
                bf16x8 sb[2];
#pragma unroll
                for (int d = 0; d < 2; ++d) { u32x4 sw; sw.x = pk2s(S[2 * T][d][0], S[2 * T][d][1]); sw.y = pk2s(S[2 * T][d][2], S[2 * T][d][3]); sw.z = pk2s(S[2 * T + 1][d][0], S[2 * T + 1][d][1]); sw.w = pk2s(S[2 * T + 1][d][2], S[2 * T + 1][d][3]); sb[d] = __builtin_bit_cast(bf16x8, sw); }
#pragma unroll
                for (int tt = 0; tt < 4; ++tt) { const bf16x8 a = qfp[(T * 4 + tt) * 64]; o[tt][0] = mfma16(sb[0], a, o[tt][0]); o[tt][1] = mfma16(sb[1], a, o[tt][1]); }
            }
#pragma unroll
            for (int tt = 0; tt < 4; ++tt) { const bf16x8 a0 = afp[(tt * 2 + 0) * 64], a1 = afp[(tt * 2 + 1) * 64];
                o[tt][0] = mfma16(vb00, a0, o[tt][0]); o[tt][0] = mfma16(vb01, a1, o[tt][0]); o[tt][1] = mfma16(vb10, a0, o[tt][1]); o[tt][1] = mfma16(vb11, a1, o[tt][1]); }
            bf16* op = F_obuf + (size_t)(b * SEQ + n * 64 + r) * 2048 + h * 512 + 128 * q4 + 32 * w + 4 * g;
#pragma unroll
            for (int tt = 0; tt < 4; ++tt)
#pragma unroll
                for (int d = 0; d < 2; ++d) { u32x2 ov; ov.x = pk2s(o[tt][d][0], o[tt][d][1]); ov.y = pk2s(o[tt][d][2], o[tt][d][3]); *(u32x2*)(op + (size_t)(16 * tt) * 2048 + 16 * d) = ov; }
            SC_BAR();
            const LAS bf16x8* kfp = (const LAS bf16x8*)bufB + lane;
            const LAS f32x4* dlp = (const LAS f32x4*)(bufB + 32768) + g;
#pragma unroll
            for (int dkt = 0; dkt < 16; ++dkt) { const f32x4 d4 = dlp[4 * dkt]; const bf16x8 k0 = kfp[(dkt * 2 + 0) * 64], k1 = kfp[(dkt * 2 + 1) * 64];
                S[dkt][0] = S[dkt][0] * d4; S[dkt][1] = S[dkt][1] * d4;
                S[dkt][0] = mfma16(k0, vb00, S[dkt][0]); S[dkt][0] = mfma16(k1, vb01, S[dkt][0]); S[dkt][1] = mfma16(k0, vb10, S[dkt][1]); S[dkt][1] = mfma16(k1, vb11, S[dkt][1]); }
            SC_BAR();
        }
    }
#undef SCAN_LOAD_A
#undef SCAN_LOAD_B
#undef SCAN_PUT_A
#undef SCAN_PUT_B
}

__device__ __forceinline__ void gla_norm_phase(Frame& F) {
    const int gw = blockIdx.x * NWAVES + F.wave, NGW = F.G * NWAVES, lane = F.lane;
    const f32x4 g0 = *(const f32x4*)(F_gla_g + lane * 8), g1 = *(const f32x4*)(F_gla_g + lane * 8 + 4);
    for (int pr = gw; pr < MTOK * 4; pr += NGW) { const int tok = pr >> 2, h = pr & 3;
        const u32x4 ow = *(const u32x4*)(F_obuf + (size_t)tok * 2048 + h * 512 + lane * 8);
        const f32x4 a = {bflo(ow.x), bfhi(ow.x), bflo(ow.y), bfhi(ow.y)}, bq = {bflo(ow.z), bfhi(ow.z), bflo(ow.w), bfhi(ow.w)};
        const float ss = (a.x * a.x + a.y * a.y) + (a.z * a.z + a.w * a.w) + (bq.x * bq.x + bq.y * bq.y) + (bq.z * bq.z + bq.w * bq.w);
        const float rstd = rsqrtf(wave_sum(ss) * (1.f / 512.f) + EPS);
        const u32x4 gw4 = *(const u32x4*)(F_proj + (size_t)tok * LDP + C_GOUT + h * 512 + lane * 8);
        float go[8] = {bflo(gw4.x), bfhi(gw4.x), bflo(gw4.y), bfhi(gw4.y), bflo(gw4.z), bfhi(gw4.z), bflo(gw4.w), bfhi(gw4.w)};
        float y[8] = {a.x * g0.x, a.y * g0.y, a.z * g0.z, a.w * g0.w, bq.x * g1.x, bq.y * g1.y, bq.z * g1.z, bq.w * g1.w};
#pragma unroll
        for (int e = 0; e < 8; ++e) y[e] = y[e] * rstd * (go[e] / (1.f + __expf(-go[e])));
        u32x4 o; o.x = pk2(y[0], y[1]); o.y = pk2(y[2], y[3]); o.z = pk2(y[4], y[5]); o.w = pk2(y[6], y[7]);
        *(u32x4*)(F_cat + (size_t)tok * LDK + 2048 + h * 512 + lane * 8) = o; }
}

struct EpiResid {
    static constexpr bool PERM = false, AFTER_DRAIN = false;
    const float* x; const float* mod; bf16* x1;
    __device__ __forceinline__ void operator()(const pg8::f32x4 (&acc)[2][2][4][2], const pg8::Unit& u, int wr, int wc, int fr, int fq) const {
        const int row0 = u.pm * 256 + wr * 64 + fr, col0 = u.pn * 256 + wc * 32 + 4 * fq;
        const int b = (u.pm * 256) / SEQ;
        const float* gp = mod + (size_t)b * NMOD + 2 * DM + col0;
        pg8::f32x4 gv[2][2];
#pragma unroll
        for (int bj = 0; bj < 2; ++bj)
#pragma unroll
            for (int n = 0; n < 2; ++n) gv[bj][n] = *(const pg8::f32x4*)(gp + bj * 128 + n * 16);
#pragma unroll
        for (int ai = 0; ai < 2; ++ai)
#pragma unroll
            for (int m = 0; m < 4; ++m) { const size_t off = (size_t)(row0 + ai * 128 + m * 16) * DM + col0;
#pragma unroll
                for (int bj = 0; bj < 2; ++bj)
#pragma unroll
                    for (int n = 0; n < 2; ++n) { const pg8::f32x4 xv = *(const pg8::f32x4*)(x + off + bj * 128 + n * 16); const pg8::f32x4 y = xv + gv[bj][n] * acc[ai][bj][m][n];
                        u32x2 o; o.x = pk2(y.x, y.y); o.y = pk2(y.z, y.w); *(u32x2*)(x1 + off + bj * 128 + n * 16) = o; } }
    }
};

__device__ __forceinline__ float gelu_erf(float v) { return 0.5f * v * (1.f + erff(v * 0.70710678118654752f)); }
__device__ __forceinline__ void wave_argmax(float& bv, int& bi) {
#pragma unroll
    for (int o = 32; o >= 1; o >>= 1) { const float ov = __shfl_xor(bv, o); const int oi = __shfl_xor(bi, o); if (ov > bv || (ov == bv && oi < bi)) { bv = ov; bi = oi; } }
}
template <int CTRL> __device__ __forceinline__ float dpp_add(float v) { return v + __builtin_bit_cast(float, __builtin_amdgcn_update_dpp(0, __builtin_bit_cast(int, v), CTRL, 0xf, 0xf, true)); }
__device__ __forceinline__ unsigned mono_key(float v) { const unsigned b = __builtin_bit_cast(unsigned, v); return (b & 0x80000000u) ? ~b : (b | 0x80000000u); }
__device__ __forceinline__ float unmono(unsigned u) { const unsigned b = (u & 0x80000000u) ? (u ^ 0x80000000u) : ~u; return __builtin_bit_cast(float, b); }
template <int CTRL> __device__ __forceinline__ unsigned dpp_u(unsigned v) { return (unsigned)__builtin_amdgcn_update_dpp(0, (int)v, CTRL, 0xf, 0xf, true); }
__device__ __forceinline__ unsigned med3u(unsigned a, unsigned b, unsigned c) { unsigned r; asm("v_med3_u32 %0, %1, %2, %3" : "=v"(r) : "v"(a), "v"(b), "v"(c)); return r; }
#define INS16(top, val) do { const unsigned v_ = (val); unsigned n_[16]; n_[0] = top[0] > v_ ? top[0] : v_; \
    _Pragma("unroll") for (int j_ = 1; j_ < 16; ++j_) n_[j_] = med3u(top[j_ - 1], v_, top[j_]); \
    _Pragma("unroll") for (int j_ = 0; j_ < 16; ++j_) top[j_] = n_[j_]; } while (0)
struct EpiKeys {
    static constexpr bool PERM = false, AFTER_DRAIN = false;
    unsigned* SK;
    __device__ __forceinline__ void operator()(const pg8::f32x4 (&acc)[2][2][4][2], const pg8::Unit& u, int wr, int wc, int fr, int fq) const {
        const int row0 = u.pm * 256 + wr * 64 + fr, kc = wc * 32 + 4 * fq, col0 = u.pn * 256 + kc;
#pragma unroll
        for (int ai = 0; ai < 2; ++ai)
#pragma unroll
            for (int m = 0; m < 4; ++m) { unsigned* rowp = SK + (size_t)(row0 + ai * 128 + m * 16) * 2048 + col0;
#pragma unroll
                for (int bj = 0; bj < 2; ++bj)
#pragma unroll
                    for (int n = 0; n < 2; ++n) { const pg8::f32x4 v = acc[ai][bj][m][n]; const unsigned k0 = (unsigned)(127 - (kc + 16 * n));
                        u32x4 o; o.x = (mono_key(v[0]) & ~127u) | k0; o.y = (mono_key(v[1]) & ~127u) | (k0 - 1u); o.z = (mono_key(v[2]) & ~127u) | (k0 - 2u); o.w = (mono_key(v[3]) & ~127u) | (k0 - 3u);
                        *(u32x4*)(rowp + bj * 128 + n * 16) = o; } }
    }
};
constexpr int KS_LD = 130;
__device__ __forceinline__ void peer_select_phase(Frame& F) {
    const int tid = F.tid;
    LAS unsigned* KS = (LAS unsigned*)(F.lds + PH_OFF);
    LAS unsigned char* IL = (LAS unsigned char*)(KS + 256 * KS_LD);
    pg8::StaticOrder S; S.init(MTOK, 2048, F.G, (int)blockIdx.x);
    for (int it2 = 0; ; ++it2) {
        pg8::Unit un; if (!S.next(it2 >> 1, un)) break;
        const int tok0 = un.pm * 256 + (it2 & 1) * 128, hh = un.pn;
        {
#pragma unroll 8
            for (int e = tid; e < 256 * 32; e += NTHR) { const int L = e >> 5, c4 = (e & 31) * 4;
                const u32x4 v = *(const u32x4*)(F_sk + (size_t)(tok0 + (L >> 1)) * 2048 + hh * 256 + (L & 1) * 128 + c4);
                LAS unsigned* d = KS + L * KS_LD + (c4 >> 6) * 65 + (c4 & 63); d[0] = v.x; d[1] = v.y; d[2] = v.z; d[3] = v.w; }
        }
        __syncthreads();
        const int L = tid >> 1, half = tid & 1;
        unsigned top[16];
#pragma unroll
        for (int j = 0; j < 16; ++j) top[j] = 0u;
        {
            const LAS unsigned* kp = KS + L * KS_LD + half * 65;
#pragma unroll 4
            for (int i = 0; i < 64; ++i) INS16(top, kp[i]);
        }
        {
            unsigned oth[16];
#pragma unroll
            for (int j = 0; j < 16; ++j) oth[j] = dpp_u<0xB1>(top[j]);
#pragma unroll
            for (int j = 0; j < 16; ++j) INS16(top, oth[j]);
        }
        if (half == 0) {
#pragma unroll
            for (int j4 = 0; j4 < 4; ++j4) { unsigned pw = 0u;
#pragma unroll
                for (int j = 0; j < 4; ++j) pw |= (127u - (top[4 * j4 + j] & 127u)) << (8 * j);
                *(LAS unsigned*)(IL + L * 16 + 4 * j4) = pw; }
        }
        unsigned t2[16];
        {
            float f1[16], f2[16];
#pragma unroll
            for (int j = 0; j < 16; ++j) { const unsigned o = dpp_u<0x4E>(top[j]); const bool p1 = (tid & 2) != 0;
                f1[j] = unmono((p1 ? o : top[j]) & ~127u); f2[j] = unmono((p1 ? top[j] : o) & ~127u); }
#pragma unroll
            for (int j = 0; j < 16; ++j) t2[j] = 0u;
#pragma unroll
            for (int a = 0; a < 16; ++a)
#pragma unroll
                for (int b = 0; b < 16; ++b) if ((a + 1) * (b + 1) <= 16) { const float sm = f1[a] + f2[b]; INS16(t2, (mono_key(sm) & ~255u) | (unsigned)(255 - (a * 16 + b))); }
        }
        __syncthreads();
        if ((tid & 3) == 0) {
            const int th = tid >> 2, tl = th, h = hh, L0 = th * 2;
            float ex[16]; const float mx = unmono(t2[0] & ~255u); float den = 0.f;
#pragma unroll
            for (int j = 0; j < 16; ++j) { ex[j] = __expf(unmono(t2[j] & ~255u) - mx); den += ex[j]; }
            const float inv = 1.f / den;
#pragma unroll
            for (int j = 0; j < 16; ++j) { const unsigned cand = 255u - (t2[j] & 255u); const unsigned e = (unsigned)IL[L0 * 16 + (cand >> 4)] * 128u + (unsigned)IL[(L0 + 1) * 16 + (cand & 15u)];
                const int k = h * 16 + j, kp2 = (k & 7) * 16 + (k >> 3); const size_t o = (size_t)(tok0 + tl) * 128 + kp2;
                F_pidx[o] = (unsigned short)e; F_gate[o] = ex[j] * inv; }
        }
        __syncthreads();
    }
}

template <int NS, int TAPER, int FINE, class Body> __device__ __forceinline__ void peer_sliced_queue(Frame& F, unsigned* heads, Body body) {
#define PCHQ(s_) ((s_) >= TAPER ? FINE : 128)
    volatile LAS int* qw = (volatile LAS int*)(F.lds + MISC_OFF + 64);
    const unsigned x = xb_xcc_id() & 7u;
    unsigned long long done = 0ull;
    for (int pass = 0; pass < NS / 8 + 1; ++pass) {
        for (;;) {
            int s;
            if (pass < NS / 8) s = (int)((x + 8u * (unsigned)pass) & (unsigned)(NS - 1));
            else {
                if (F.wave == 0) { const unsigned v = F.lane < NS ? __hip_atomic_load(heads + 64 * F.lane, __ATOMIC_RELAXED, __HIP_MEMORY_SCOPE_AGENT) : 0xffffffffu;
                    const unsigned long long m = __ballot(v < (unsigned)(MTOK / PCHQ(F.lane & (NS - 1)))) & ~done; if (F.lane == 0) qw[1] = m ? (int)__builtin_ctzll(m) : -1; }
                __syncthreads(); s = qw[1]; __syncthreads();
                if (s < 0) break;
            }
            if (F.tid == 0) qw[0] = (int)__hip_atomic_fetch_add(heads + 64 * s, 1u, __ATOMIC_RELAXED, __HIP_MEMORY_SCOPE_AGENT);
            __syncthreads(); int c = qw[0]; __syncthreads();
            const int npch = MTOK / PCHQ(s);
            while (c < npch) {
                if (F.tid == 0) qw[0] = (int)__hip_atomic_fetch_add(heads + 64 * s, 1u, __ATOMIC_RELAXED, __HIP_MEMORY_SCOPE_AGENT);
                body(s, c);
                __syncthreads(); c = qw[0]; __syncthreads();
            }
            done |= 1ull << s;
            if (pass < NS / 8) break;
        }
    }
}
#undef PCHQ
typedef float f32x2v __attribute__((ext_vector_type(2)));
template <int CTRL> __device__ __forceinline__ int dpp_addi(int v) { return v + __builtin_amdgcn_update_dpp(0, v, CTRL, 0xf, 0xf, true); }
constexpr int NSLU = 16, UTAPER = 8, UFINE = 64;
__device__ __forceinline__ void peer_u_chunk(Frame& F, int s, int c) {
    const int lane = F.lane, p = lane >> 3, q = lane & 7;
    const unsigned char* ub = F_u8 + (size_t)s * ((size_t)NEXP * 128) + 16 * q;
    const int pch8 = (s >= UTAPER ? UFINE : 128) >> 3;
#pragma unroll 1
    for (int i = 0; i < pch8; ++i) {
        const int t = (c * 8 + F.wave) * pch8 + i;
        const u32x4 hH = *(const u32x4*)(F_h8 + (size_t)t * 2048 + 128 * s + 16 * q);
        const u32x4 hL = *(const u32x4*)(F_h8 + (size_t)MTOK * 2048 + (size_t)t * 2048 + 128 * s + 16 * q);
        const u32x4* ip = (const u32x4*)(F_pidx + (size_t)t * 128 + p * 16);
        const u32x4 i0 = ip[0], i1 = ip[1];
        const unsigned iw[8] = {i0.x, i0.y, i0.z, i0.w, i1.x, i1.y, i1.z, i1.w};
        u32x4 a[16];
#pragma unroll
        for (int st = 0; st < 16; ++st) { const unsigned id = (st & 1) ? (iw[st >> 1] >> 16) : (iw[st >> 1] & 0xffffu); a[st] = *(const u32x4*)(ub + (size_t)id * 128); }
        const int hh[4] = {(int)hH.x, (int)hH.y, (int)hH.z, (int)hH.w}, hl[4] = {(int)hL.x, (int)hL.y, (int)hL.z, (int)hL.w};
        int sh = 0, sl = 0;
#pragma unroll
        for (int d = 0; d < 4; ++d) { sh = __builtin_amdgcn_sdot8(hh[d], 0x11111111, sh, false); sl = __builtin_amdgcn_sdot8(hl[d], 0x11111111, sl, false); }
        const int cst = 16 * sh + sl;
        int dv[16];
#pragma unroll
        for (int st = 0; st < 16; ++st) {
            const int xw[4] = {(int)a[st].x, (int)a[st].y, (int)a[st].z, (int)a[st].w};
            int dh = 0, dl = 0;
#pragma unroll
            for (int dd = 0; dd < 4; ++dd) { dh = __builtin_amdgcn_sdot8(xw[dd], hh[dd], dh, false); dl = __builtin_amdgcn_sdot8(xw[dd], hl[dd], dl, false); }
            dv[st] = 32 * dh + 2 * dl + cst; }
        int v8[8], v4[4], v2[2];
        { const bool b0 = (q & 1) != 0;
#pragma unroll
          for (int j = 0; j < 8; ++j) { const int keep = b0 ? dv[j + 8] : dv[j], send = b0 ? dv[j] : dv[j + 8]; v8[j] = keep + __builtin_amdgcn_update_dpp(0, send, 0xB1, 0xf, 0xf, true); } }
        { const bool b1 = (q & 2) != 0;
#pragma unroll
          for (int j = 0; j < 4; ++j) { const int keep = b1 ? v8[j + 4] : v8[j], send = b1 ? v8[j] : v8[j + 4]; v4[j] = keep + __builtin_amdgcn_update_dpp(0, send, 0x4E, 0xf, 0xf, true); } }
        { const bool b2 = (q & 4) != 0;
#pragma unroll
          for (int j = 0; j < 2; ++j) { const int keep = b2 ? v4[j + 2] : v4[j], send = b2 ? v4[j] : v4[j + 2];
              int x = __builtin_amdgcn_update_dpp(0, send, 0x104, 0xf, 0x5, false);
              x = __builtin_amdgcn_update_dpp(x, send, 0x114, 0xf, 0xa, false);
              v2[j] = keep + x; } }
        const int st0 = 8 * (q & 1) + 4 * ((q >> 1) & 1) + 2 * (q >> 2);
        *(unsigned*)(F_part + ((size_t)s * MTOK + t) * 128 + p * 16 + st0) = pk2((float)v2[0], (float)v2[1]);
    }
}
__device__ __forceinline__ void peer_reduce_phase(Frame& F) {
    const size_t gt = (size_t)blockIdx.x * NTHR + F.tid, NT = (size_t)F.G * NTHR;
    for (size_t i = gt; i < (size_t)MTOK * 128 / 4; i += NT) {
        f32x4 a = {0.f, 0.f, 0.f, 0.f};
#pragma unroll 8
        for (int s = 0; s < NSLU; ++s) { const u32x2 pw = *(const u32x2*)(F_part + (size_t)s * MTOK * 128 + 4 * i); a += (f32x4){bflo(pw.x), bfhi(pw.x), bflo(pw.y), bfhi(pw.y)}; }
        const f32x4 gt4 = *(const f32x4*)(F_gate + 4 * i);
        const u32x2 id2 = *(const u32x2*)(F_pidx + 4 * i);
        const unsigned e0 = id2.x & 0xffffu, e1 = id2.x >> 16, e2 = id2.y & 0xffffu, e3 = id2.y >> 16;
        a = a * (0.5f * F_hinv[i >> 5]);
        f32x4 o; o.x = gt4.x * gelu_erf(a.x * F_isu[e0]) * F_isv[e0]; o.y = gt4.y * gelu_erf(a.y * F_isu[e1]) * F_isv[e1];
        o.z = gt4.z * gelu_erf(a.z * F_isu[e2]) * F_isv[e2]; o.w = gt4.w * gelu_erf(a.w * F_isu[e3]) * F_isv[e3];
        float wm = fmaxf(fmaxf(fabsf(o.x), fabsf(o.y)), fmaxf(fabsf(o.z), fabsf(o.w)));
#pragma unroll
        for (int sh = 1; sh < 32; sh <<= 1) wm = fmaxf(wm, __shfl_xor(wm, sh));
        const float sc = wm > 0.f ? 127.f / wm : 1.f;
        *(unsigned*)(F_wq + 4 * i) = q8x4(o * sc);
        if ((i & 31) == 0) F_wsc[i >> 5] = wm > 0.f ? wm * (1.f / 127.f) : 1.f;
    }
}
__device__ __forceinline__ void tr4x4(unsigned r0, unsigned r1, unsigned r2, unsigned r3, unsigned& c0, unsigned& c1, unsigned& c2, unsigned& c3) {
    const unsigned t01l = __builtin_amdgcn_perm(r1, r0, 0x05010400u), t01h = __builtin_amdgcn_perm(r1, r0, 0x07030602u);
    const unsigned t23l = __builtin_amdgcn_perm(r3, r2, 0x05010400u), t23h = __builtin_amdgcn_perm(r3, r2, 0x07030602u);
    c0 = __builtin_amdgcn_perm(t23l, t01l, 0x05040100u); c1 = __builtin_amdgcn_perm(t23l, t01l, 0x07060302u);
    c2 = __builtin_amdgcn_perm(t23h, t01h, 0x05040100u); c3 = __builtin_amdgcn_perm(t23h, t01h, 0x07060302u);
}
__device__ __forceinline__ void peer_v_chunk(Frame& F, int s, int c) {
    const int lane = F.lane, p = lane >> 3, q = lane & 7;
    const unsigned char* vb = F_v8 + (size_t)s * ((size_t)NEXP * SLW) + 16 * q;
    const int pch8 = pch_of(s) >> 3;
#pragma unroll 1
    for (int i = 0; i < pch8; ++i) {
        const int t = (c * 8 + F.wave) * pch8 + i;
        const u32x4* ip = (const u32x4*)(F_pidx + (size_t)t * 128 + p * 16);
        const u32x4 i0 = ip[0], i1 = ip[1];
        const unsigned iw[8] = {i0.x, i0.y, i0.z, i0.w, i1.x, i1.y, i1.z, i1.w};
        const u32x4 wq4 = *(const u32x4*)(F_wq + (size_t)t * 128 + p * 16);
        const unsigned wqm[4] = {wq4.x, wq4.y, wq4.z, wq4.w};
        u32x4 a[16];
#pragma unroll
        for (int st = 0; st < 16; ++st) { const unsigned id = (st & 1) ? (iw[st >> 1] >> 16) : (iw[st >> 1] & 0xffffu); a[st] = *(const u32x4*)(vb + (size_t)id * SLW); }
        int acc[16];
#pragma unroll
        for (int j = 0; j < 16; ++j) acc[j] = 0;
#pragma unroll
        for (int m = 0; m < 4; ++m) {
            const unsigned r0[4] = {a[4 * m].x, a[4 * m].y, a[4 * m].z, a[4 * m].w}, r1[4] = {a[4 * m + 1].x, a[4 * m + 1].y, a[4 * m + 1].z, a[4 * m + 1].w};
            const unsigned r2[4] = {a[4 * m + 2].x, a[4 * m + 2].y, a[4 * m + 2].z, a[4 * m + 2].w}, r3[4] = {a[4 * m + 3].x, a[4 * m + 3].y, a[4 * m + 3].z, a[4 * m + 3].w};
#pragma unroll
            for (int wd = 0; wd < 4; ++wd) { unsigned c0, c1, c2, c3; tr4x4(r0[wd], r1[wd], r2[wd], r3[wd], c0, c1, c2, c3);
                acc[4 * wd] = __builtin_amdgcn_sdot4((int)c0, (int)wqm[m], acc[4 * wd], false); acc[4 * wd + 1] = __builtin_amdgcn_sdot4((int)c1, (int)wqm[m], acc[4 * wd + 1], false);
                acc[4 * wd + 2] = __builtin_amdgcn_sdot4((int)c2, (int)wqm[m], acc[4 * wd + 2], false); acc[4 * wd + 3] = __builtin_amdgcn_sdot4((int)c3, (int)wqm[m], acc[4 * wd + 3], false); }
        }
        int s8[8], s4[4], s2[2];
#pragma unroll
        for (int j = 0; j < 8; ++j) { const auto r = __builtin_amdgcn_permlane32_swap((unsigned)acc[j], (unsigned)acc[j + 8], false, false); s8[j] = (int)r[0] + (int)r[1]; }
#pragma unroll
        for (int j = 0; j < 4; ++j) { const auto r = __builtin_amdgcn_permlane16_swap((unsigned)s8[j], (unsigned)s8[j + 4], false, false); s4[j] = (int)r[0] + (int)r[1]; }
        const bool hi8 = (lane & 8) != 0;
#pragma unroll
        for (int j = 0; j < 2; ++j) { const int keep = hi8 ? s4[j + 2] : s4[j], send = hi8 ? s4[j] : s4[j + 2]; s2[j] = keep + __builtin_amdgcn_update_dpp(0, send, 0x128, 0xf, 0xf, true); }
        { const float ws = F_wsc[t]; *(unsigned*)(F_po + (size_t)t * DM + SLW * s + 16 * q + 2 * p) = pk2((float)s2[0] * ws, (float)s2[1] * ws); }
    }
}
__device__ __forceinline__ void final_phase(Frame& F) {
    const int gw = blockIdx.x * NWAVES + F.wave, NGW = F.G * NWAVES, lane = F.lane;
    for (int row = gw; row < MTOK; row += NGW) {
        const int b = row / SEQ;
        const float* g2p = F_mod + (size_t)b * NMOD + 5 * DM;
        const u32x2* xr = (const u32x2*)(F_x1 + (size_t)row * DM) + lane;
        const u32x2* pr = (const u32x2*)(F_po + (size_t)row * DM) + lane;
        f32x4 v[16]; float ss = 0.f;
#pragma unroll
        for (int j = 0; j < 16; ++j) { const int col = (lane + 64 * j) * 4; const u32x2 xw = xr[64 * j]; const f32x4 xv = {bflo(xw.x), bfhi(xw.x), bflo(xw.y), bfhi(xw.y)}, gv = *(const f32x4*)(g2p + col); const u32x2 pw = pr[64 * j];
            v[j].x = xv.x + gv.x * bflo(pw.x); v[j].y = xv.y + gv.y * bfhi(pw.x); v[j].z = xv.z + gv.z * bflo(pw.y); v[j].w = xv.w + gv.w * bfhi(pw.y);
            ss += (v[j].x * v[j].x + v[j].y * v[j].y) + (v[j].z * v[j].z + v[j].w * v[j].w); }
        const float rstd = rsqrtf(wave_sum(ss) * (1.f / DM) + EPS);
        f32x4* op = (f32x4*)(F_out + (size_t)row * DM) + lane;
#pragma unroll
        for (int j = 0; j < 16; ++j) { const int col = (lane + 64 * j) * 4; op[64 * j] = v[j] * rstd * *(const f32x4*)(F_final_g + col); }
    }
}

__global__ void __launch_bounds__(NTHR, 2) hybrid_fwd(Args args) {
    extern __shared__ __attribute__((aligned(16))) unsigned char lds_raw[];
    Frame F;
    F.lds = (LAS unsigned char*)lds_raw;
    F.tid = threadIdx.x; F.lane = F.tid & 63; F.wave = __builtin_amdgcn_readfirstlane(F.tid >> 6); F.G = gridDim.x;
    F.in = args.in; F.out = args.out; F.ws = args.ws;
    unsigned char* ws = args.ws;
    volatile LAS unsigned* MISC = (volatile LAS unsigned*)(F.lds + MISC_OFF);
    if (F.tid < 64) MISC[F.tid] = 0u;
    __syncthreads();
    unsigned* ctl = (unsigned*)(ws + WS_CTL);
    XcdBarrier bar; bar.bar = ctl + CW_BAR + args.li * XCD_BAR_WORDS; bar.x = 0; bar.st = nullptr;
    if (MK_N_LAUNCHES != NPHASE) bar = xcd_barrier_post(ctl + CW_BAR + args.li * XCD_BAR_WORDS, MISC + 8);
    const int lo = args.ph_lo, hi = args.ph_hi;
#ifndef PH_MASK
#define PH_MASK 0x3fff
#endif
#define IN(k) (((PH_MASK >> (k)) & 1) && lo <= (k) && (k) < hi)
#define SEAM(k) do { if (IN(k) && IN((k) + 1)) xcd_barrier(bar); LAUNDER_IDS(F); } while (0)
#ifndef REP_MASK
#define REP_MASK 0
#endif
#define NREP(k) ((((REP_MASK) >> (k)) & 1) ? 2 : 1)
    LAS unsigned char* gl = F.lds + PH_OFF;

    if (IN(0)) { _Pragma("unroll") for (int rep = 0; rep < NREP(0); ++rep) { if (rep) xcd_barrier(bar); p0_prologue(F); } }
    SEAM(0);
    if (IN(1)) { _Pragma("unroll") for (int rep = 0; rep < NREP(1); ++rep) { if (rep) xcd_barrier(bar); norm_mod_phase<false, false>(F, F_x, F_norm1_g, 0 * DM, 1 * DM, F_hb); } }
    SEAM(1);
    if (IN(2)) { _Pragma("unroll") for (int rep = 0; rep < NREP(2); ++rep) { if (rep) xcd_barrier(bar);
        pg8::Gemm gm{F_hb, F_win_t, MTOK, LDP, DM, LDK}; pg8::StaticOrder S; S.init(MTOK, LDP, F.G, (int)blockIdx.x);
        pg8::EpiBf16<0> E{F_proj, LDP, nullptr, 0, 0};
        pg8::gemm_phase<pg8::EpiBf16<0>, pg8::StaticOrder, false>(gl, gm, S, E, nullptr);
        __syncthreads();
        const int c2 = (int)((blockIdx.x + F.G - 96u) % (unsigned)F.G);
        { pg8::Gemm gv{F_win_t + (size_t)C_AV * LDK, F_hb, 256, MTOK, DM, LDK}; pg8::StaticOrder S2; S2.init(256, MTOK, F.G, c2);
          pg8::EpiBf16<0> E2{F_vt, MTOK, nullptr, 0, 0};
          pg8::gemm_phase<pg8::EpiBf16<0>, pg8::StaticOrder, false>(gl, gv, S2, E2, nullptr); }
        { pg8::Unit u5; if (!S.next(4, u5) && c2 >= 32) cvt_pull(F, ctl + CW_CVT, P2_CVT_BATCHES); } }
    }
    SEAM(2);
    if (IN(3)) { _Pragma("unroll") for (int rep = 0; rep < NREP(3); ++rep) { if (rep) xcd_barrier(bar);
        for (int it = blockIdx.x; it < 512; it += F.G) gla_prep_item(F, it);
        }
    }
    SEAM(3);
    if (IN(4)) { _Pragma("unroll") for (int rep = 0; rep < NREP(4); ++rep) { if (rep) xcd_barrier(bar); if (F.G > 64) { if (blockIdx.x < 64) { gla_scan_lds(F, (int)blockIdx.x); __syncthreads(); LAUNDER_IDS(F); trans_pull(F, (LAS float*)(F.lds + PH_OFF + F.wave * 8448)); cvt_pull(F, ctl + CW_CVT, 1 << 20); } else { LAUNDER_IDS(F); p4_side(F, (int)blockIdx.x - 64, F.G - 64); } }
        else { for (int it = blockIdx.x; it < 64; it += F.G) gla_scan_lds(F, it); __syncthreads(); p4_side(F, (int)blockIdx.x, F.G); } } }
    SEAM(4);
    if (IN(5)) { _Pragma("unroll") for (int rep = 0; rep < NREP(5); ++rep) { if (rep) xcd_barrier(bar); gla_norm_phase(F); } }
    SEAM(5);
    if (IN(6)) { _Pragma("unroll") for (int rep = 0; rep < NREP(6); ++rep) { if (rep) xcd_barrier(bar);
        pg8::Gemm gm{F_cat, F_wout_t, MTOK, DM, DM, LDK}; pg8::StaticOrder S; S.init(MTOK, DM, F.G, (int)blockIdx.x);
        EpiResid E{F_x, F_mod, F_x1};
        pg8::gemm_phase<EpiResid, pg8::StaticOrder, false>(gl, gm, S, E, nullptr); }
    }
    SEAM(6);
    if (IN(7)) { _Pragma("unroll") for (int rep = 0; rep < NREP(7); ++rep) { if (rep) xcd_barrier(bar); norm_mod_phase<true, true>(F, F_x1, F_norm2_g, 3 * DM, 4 * DM, F_hb); } }
    SEAM(7);
    if (IN(8)) { _Pragma("unroll") for (int rep = 0; rep < NREP(8); ++rep) { if (rep) xcd_barrier(bar);
        pg8::Gemm gm{F_hb, F_wq_t, MTOK, 2048, DM, LDK}; pg8::StaticOrder S; S.init(MTOK, 2048, F.G, (int)blockIdx.x);
        EpiKeys E{F_sk};
        pg8::gemm_phase<EpiKeys, pg8::StaticOrder, false>(gl, gm, S, E, nullptr); }
    }
    if (IN(8) && IN(9)) { asm volatile("s_waitcnt vmcnt(0)" ::: "memory"); __syncthreads(); }
    LAUNDER_IDS(F);
    if (IN(9)) { _Pragma("unroll") for (int rep = 0; rep < NREP(9); ++rep) { if (rep) xcd_barrier(bar); peer_select_phase(F); } }
    SEAM(9);
    if (IN(10)) { _Pragma("unroll") for (int rep = 0; rep < NREP(10); ++rep) { if (rep) xcd_barrier(bar); peer_sliced_queue<NSLU, UTAPER, UFINE>(F, ctl + CW_QU + rep * 8192, [&](int s_, int c_) { peer_u_chunk(F, s_, c_); }); } }
    SEAM(10);
    if (IN(11)) { _Pragma("unroll") for (int rep = 0; rep < NREP(11); ++rep) { if (rep) xcd_barrier(bar); peer_reduce_phase(F); } }
    SEAM(11);
    if (IN(12)) { _Pragma("unroll") for (int rep = 0; rep < NREP(12); ++rep) { if (rep) xcd_barrier(bar); peer_sliced_queue<NSL, 24, 32>(F, ctl + CW_QV + rep * 8192, [&](int s_, int c_) { peer_v_chunk(F, s_, c_); }); } }
    SEAM(12);
    if (IN(13)) { _Pragma("unroll") for (int rep = 0; rep < NREP(13); ++rep) { if (rep) xcd_barrier(bar); final_phase(F); } }
#undef IN
#undef SEAM
}

extern "C" void kernel_launch(void* const* d_in, const int* in_sizes, int n_in, void* d_out, int out_size, void* d_ws, size_t ws_size, hipStream_t stream) {
    static int grid = 0;
    if (grid == 0) {
        if (n_in != 18 || out_size != MTOK * DM || ws_size < WS_END) { fprintf(stderr, "kernel_launch: unexpected shapes (n_in %d, out %d, ws %zu); nothing launched\n", n_in, out_size, ws_size); grid = -1; return; }
        int dev = 0, cus = 0, per_cu = 0;
        if (hipGetDevice(&dev) != hipSuccess || hipDeviceGetAttribute(&cus, hipDeviceAttributeMultiprocessorCount, dev) != hipSuccess) { grid = -1; return; }
        if (hipFuncSetAttribute((const void*)hybrid_fwd, hipFuncAttributeMaxDynamicSharedMemorySize, LDS_BYTES) != hipSuccess) { fprintf(stderr, "kernel_launch: hipFuncSetAttribute failed\n"); grid = -1; return; }
        if (hipOccupancyMaxActiveBlocksPerMultiprocessor(&per_cu, (const void*)hybrid_fwd, NTHR, LDS_BYTES) != hipSuccess || per_cu < 1) { fprintf(stderr, "kernel_launch: occupancy query says %d workgroups per CU\n", per_cu); }
        (void)hipGetLastError();
        grid = cus;
    }
    if (grid < 0) return;
    if (hipMemsetAsync((char*)d_ws + WS_CTL, 0, CTL_ZERO_BYTES, stream) != hipSuccess) { fprintf(stderr, "kernel_launch: memset failed\n"); return; }
    Args a{};
    for (int i = 0; i < 18; ++i) a.in[i] = (const float*)d_in[i];
    a.out = (float*)d_out; a.ws = (unsigned char*)d_ws;
    for (int li = 0; li < MK_N_LAUNCHES; ++li) {
        if (MK_N_LAUNCHES == NPHASE) { a.ph_lo = li; a.ph_hi = li + 1; } else { a.ph_lo = 0; a.ph_hi = NPHASE; }
        a.li = (MK_N_LAUNCHES == NPHASE) ? 0 : li;
        hipLaunchKernelGGL(hybrid_fwd, dim3(grid), dim3(NTHR), LDS_BYTES, stream, a);
        const hipError_t le = hipPeekAtLastError();
        if (le != hipSuccess) { fprintf(stderr, "kernel_launch: launch %d failed: %s\n", li, hipGetErrorName(le)); break; }
    }
}
```

```cpp
#include <hip/hip_runtime.h>
#include <cstdio>
#include <cstdint>
namespace pg8 {
#define PG8_LAS __attribute__((address_space(3)))
typedef unsigned short bf16_t;
typedef short bf16x8 __attribute__((ext_vector_type(8)));
typedef float f32x4 __attribute__((ext_vector_type(4)));
typedef unsigned u32x4 __attribute__((ext_vector_type(4)));
constexpr int BM = 256, BK = 64, HALF = 128, HTB = HALF * BK * 2  , STAGE_BYTES = 8 * HTB, NXCD = 8, WGM = 8;

__host__ __device__ __forceinline__ int lds_byte(int r, int c) { const int st = (r >> 4) * 2 + (c >> 5), rr = r & 15, cc = c & 31, ob = rr * 64 + cc * 2; return st * 1024 + (ob ^ (((ob >> 9) & 1) << 5)); }
__host__ __device__ __forceinline__ void stage_rc(int b, int& R, int& C) { const int st = b / 1024, sb = b % 1024, swz = sb ^ (((sb >> 9) & 1) << 5); R = (st >> 1) * 16 + swz / 64; C = (st & 1) * 32 + (swz % 64) / 2; }
__host__ __device__ __forceinline__ int perm32(int rho) { const int n = rho >> 4, i = rho & 15; return 8 * (i >> 2) + 4 * n + (i & 3); }

struct Unit { int pm, pn; };
struct Gemm { const bf16_t* A; const bf16_t* Bt; int M, N, K, ld; };

struct StaticOrder {
    int nM, nN, nwg, G, c;
    __host__ __device__ void init(int M, int N, int G_, int c_) { nM = M / BM; nN = N / BM; nwg = nM * nN; G = G_; c = c_; }
    __host__ __device__ bool next(int i, Unit& u) const {
        const long L = (long)i * G + c; if (L >= nwg) return false;
        int wgid = (int)L; { const int q = nwg / NXCD, r = nwg % NXCD, xcd = wgid % NXCD, off = wgid / NXCD; wgid = (xcd < r ? xcd * (q + 1) : r * (q + 1) + (xcd - r) * q) + off; }
        const int nig = WGM * nN, gid = wgid / nig, fm = gid * WGM, gsz = (nM - fm) < WGM ? (nM - fm) : WGM;
        u.pm = fm + ((wgid % nig) % gsz); u.pn = (wgid % nig) / gsz; return true;
    }
    __device__ __forceinline__ void a_ready(const Unit&) const {}
    __device__ __forceinline__ void done(const Unit&) const {}
};
__device__ __forceinline__ unsigned cvt_pk_bf16(float lo, float hi) { unsigned r; asm volatile("v_cvt_pk_bf16_f32 %0, %1, %2" : "=v"(r) : "v"(lo), "v"(hi)); return r; }
typedef float f32x2 __attribute__((ext_vector_type(2)));
__device__ __forceinline__ f32x2 gelu_pk(f32x2 v) {
    const f32x2 av = __builtin_elementwise_abs(v), d = av * 0.2316418882f + 1.0f;
    f32x2 t; t.x = __builtin_amdgcn_rcpf(d.x); t.y = __builtin_amdgcn_rcpf(d.y);
    f32x2 q = t * 0.5307027145f + (-0.7265760135f); q = q * t + 0.7107068705f; q = q * t + (-0.142248368f); q = q * t + 0.127414796f; q = q * t;
    const f32x2 s = (v * v) * (-0.72134752044f);
    f32x2 e; e.x = __builtin_amdgcn_exp2f(s.x); e.y = __builtin_amdgcn_exp2f(s.y);
    const f32x2 m = v * (q * e), r = v - m;
    f32x2 o; o.x = v.x < 0.f ? m.x : r.x; o.y = v.y < 0.f ? m.y : r.y; return o;
}

struct EpiF32 {
    static constexpr bool PERM = false, AFTER_DRAIN = false;
    float* C; int ldc; const float* bias;
    __device__ __forceinline__ void operator()(const f32x4 (&acc)[2][2][4][2], const Unit& u, int wr, int wc, int fr, int fq) const {
        const int row0 = u.pm * BM + wr * 64 + fr, col0 = u.pn * BM + wc * 32 + 4 * fq;
        f32x4 bv[2][2];
#pragma unroll
        for (int bj = 0; bj < 2; ++bj)
#pragma unroll
            for (int n = 0; n < 2; ++n) bv[bj][n] = bias ? *(const f32x4*)(bias + col0 + bj * HALF + n * 16) : (f32x4){0.f, 0.f, 0.f, 0.f};
#pragma unroll
        for (int ai = 0; ai < 2; ++ai)
#pragma unroll
            for (int m = 0; m < 4; ++m) { float* rowp = C + (size_t)(row0 + ai * HALF + m * 16) * ldc + col0;
#pragma unroll
                for (int bj = 0; bj < 2; ++bj)
#pragma unroll
                    for (int n = 0; n < 2; ++n) *(f32x4*)(rowp + bj * HALF + n * 16) = acc[ai][bj][m][n] + bv[bj][n]; }
    }
};
template <int ACT  > struct EpiBf16 {
    static constexpr bool PERM = true, AFTER_DRAIN = false;
    bf16_t* O; int ldc; const float* bias; int split_cols; size_t split_stride;
    __device__ __forceinline__ void operator()(const f32x4 (&acc)[2][2][4][2], const Unit& u, int wr, int wc, int fr, int fq) const {
        const int row0 = u.pm * BM + wr * 64 + fr; int colt = u.pn * BM; bf16_t* base = O;
        if (split_cols) { const int t = colt / split_cols; base += (size_t)t * split_stride; colt -= t * split_cols; }
        const int col0 = colt + wc * 32 + 8 * fq, bcol0 = u.pn * BM + wc * 32 + 8 * fq;
        f32x4 bv[2][2];
#pragma unroll
        for (int bj = 0; bj < 2; ++bj)
#pragma unroll
            for (int n = 0; n < 2; ++n) bv[bj][n] = bias ? *(const f32x4*)(bias + bcol0 + bj * HALF + 4 * n) : (f32x4){0.f, 0.f, 0.f, 0.f};
#pragma unroll
        for (int ai = 0; ai < 2; ++ai)
#pragma unroll
            for (int m = 0; m < 4; ++m) { bf16_t* rowp = base + (size_t)(row0 + ai * HALF + m * 16) * ldc + col0;
#pragma unroll
                for (int bj = 0; bj < 2; ++bj) { f32x4 v0 = acc[ai][bj][m][0] + bv[bj][0], v1 = acc[ai][bj][m][1] + bv[bj][1];
                    if (ACT == 1) { f32x2 a = gelu_pk((f32x2){v0[0], v0[1]}), b = gelu_pk((f32x2){v0[2], v0[3]}), c = gelu_pk((f32x2){v1[0], v1[1]}), d = gelu_pk((f32x2){v1[2], v1[3]});
                        v0 = (f32x4){a.x, a.y, b.x, b.y}; v1 = (f32x4){c.x, c.y, d.x, d.y}; }
                    if (ACT == 2) {
#pragma unroll
                        for (int j = 0; j < 4; ++j) { v0[j] = 0.5f * v0[j] * (1.0f + erff(v0[j] * 0.70710678f)); v1[j] = 0.5f * v1[j] * (1.0f + erff(v1[j] * 0.70710678f)); } }
                    u32x4 w; w.x = cvt_pk_bf16(v0[0], v0[1]); w.y = cvt_pk_bf16(v0[2], v0[3]); w.z = cvt_pk_bf16(v1[0], v1[1]); w.w = cvt_pk_bf16(v1[2], v1[3]);
                    *(u32x4*)(rowp + bj * HALF) = w; } }
    }
};
template <class Epi, class Sched, bool STAMP = false>
__device__ __forceinline__ void gemm_phase(PG8_LAS unsigned char* lds, const Gemm g, const Sched& S, const Epi& E, unsigned long long* stamps) {
    const int tid = threadIdx.x, wid = __builtin_amdgcn_readfirstlane(tid >> 6), lane = tid & 63, wr = wid >> 2, wc = wid & 3, fr = lane & 15, fq = lane >> 4;
    const int K = g.K, nt = K / BK, LD = g.ld;
    int ts_lo = 0, ts_hi = 0, nts = 0; const unsigned long long rt_entry = STAMP ? (unsigned long long)wall_clock64() : 0ull;
#define PG8_STAMP() do { if (STAMP && wid == 0 && nts < 64) { const unsigned long long _c = (unsigned long long)clock64(); \
        ts_lo = (lane == nts) ? (int)(unsigned)_c : ts_lo; ts_hi = (lane == nts) ? (int)(unsigned)(_c >> 32) : ts_hi; ++nts; } } while (0)
    PG8_STAMP();
    unsigned voffA[2], voffB[2];
#pragma unroll
    for (int i = 0; i < 2; ++i) { int R, C; stage_rc(tid * 16 + i * 8192, R, C); const int Rb = Epi::PERM ? ((R & ~31) + perm32(R & 31)) : R;
        voffA[i] = (unsigned)(R * LD + C) * 2u; voffB[i] = (unsigned)(Rb * LD + C) * 2u; }
    const size_t kstep = (size_t)(BK * 2);
    const size_t hstep = (size_t)HALF * LD * 2;
    const size_t tstep = 2 * hstep;
    const unsigned ldsw = (unsigned)wid * 1024u;
    const int aoff = lds_byte(wr * 64 + fr, fq * 8), boff = lds_byte(wc * 32 + fr, fq * 8);
#define PG8_SA(b, h) (((b) * 2 + (h)) * HTB)
#define PG8_SB(b, h) ((4 + (b) * 2 + (h)) * HTB)
#define PG8_STAGE(bufoff, gbase, voff) do { _Pragma("unroll") for (int _i = 0; _i < 2; ++_i) \
        __builtin_amdgcn_global_load_lds((const unsigned*)((const char*)(gbase) + (voff)[_i]), (PG8_LAS unsigned*)(lds + (bufoff) + ldsw + _i * 8192), 16, 0, 0); } while (0)
#define PG8_LDA(dst, b, h) do { _Pragma("unroll") for (int m = 0; m < 4; ++m) _Pragma("unroll") for (int k = 0; k < 2; ++k) dst[m][k] = *(const PG8_LAS bf16x8*)(lds + PG8_SA(b, h) + aoff + m * 2048 + k * 1024); } while (0)
#define PG8_LDB(dst, b, h) do { _Pragma("unroll") for (int n = 0; n < 2; ++n) _Pragma("unroll") for (int k = 0; k < 2; ++k) dst[n][k] = *(const PG8_LAS bf16x8*)(lds + PG8_SB(b, h) + boff + n * 2048 + k * 1024); } while (0)
#define PG8_MMA(ai, bj, At, Bt) do { __builtin_amdgcn_s_setprio(1); _Pragma("unroll") for (int m = 0; m < 4; ++m) _Pragma("unroll") for (int n = 0; n < 2; ++n) _Pragma("unroll") for (int k = 0; k < 2; ++k) \
        acc[ai][bj][m][n] = __builtin_amdgcn_mfma_f32_16x16x32_bf16(Bt[n][k], At[m][k], acc[ai][bj][m][n], 0, 0, 0); __builtin_amdgcn_s_setprio(0); } while (0)
#define PG8_WAIT_V(n) asm volatile("s_waitcnt vmcnt(" #n ")" ::: "memory")
#define PG8_WAIT_L(n) asm volatile("s_waitcnt lgkmcnt(" #n ")" ::: "memory")
#define PG8_BAR __builtin_amdgcn_s_barrier()
#define PG8_SCHED __builtin_amdgcn_sched_barrier(0)
    Unit cur, nxt; int ui = 0;
    if (!S.next(0, cur)) return;
    f32x4 acc[2][2][4][2];
#pragma unroll
    for (int a = 0; a < 2; ++a)
#pragma unroll
        for (int b = 0; b < 2; ++b)
#pragma unroll
            for (int m = 0; m < 4; ++m)
#pragma unroll
                for (int n = 0; n < 2; ++n) acc[a][b][m][n] = (f32x4){0.f, 0.f, 0.f, 0.f};
    bf16x8 At[4][2], B0[2][2], B1[2][2];
    const char* cA = (const char*)g.A + (size_t)cur.pm * tstep; const char* cB = (const char*)g.Bt + (size_t)cur.pn * tstep;
    S.a_ready(cur);
    PG8_STAGE(PG8_SB(0, 0), cB, voffB); PG8_STAGE(PG8_SA(0, 0), cA, voffA); PG8_STAGE(PG8_SB(0, 1), cB + hstep, voffB); PG8_STAGE(PG8_SA(0, 1), cA + hstep, voffA);
    if (wr == 1) PG8_BAR;
    PG8_WAIT_V(4); PG8_BAR;
    PG8_STAGE(PG8_SB(1, 0), cB + kstep, voffB); PG8_STAGE(PG8_SA(1, 0), cA + kstep, voffA); PG8_STAGE(PG8_SB(1, 1), cB + hstep + kstep, voffB);
    PG8_WAIT_V(6); PG8_BAR;
    PG8_STAMP();
    for (;;) {
        const bool has_next = S.next(ui + 1, nxt);
        const char* nA = has_next ? (const char*)g.A + (size_t)nxt.pm * tstep : cA; const char* nB = has_next ? (const char*)g.Bt + (size_t)nxt.pn * tstep : cB;
        for (int t = 0; t < nt; t += 2) {
            const bool last = (t == nt - 2);
            const char* a1 = cA + (size_t)(t + 1) * kstep;
            const char* a2 = last ? nA : cA + (size_t)(t + 2) * kstep; const char* b2 = last ? nB : cB + (size_t)(t + 2) * kstep;
            const char* a3 = a2 + kstep; const char* b3 = b2 + kstep;
            if (last && has_next) S.a_ready(nxt);
            PG8_LDB(B0, 0, 0); PG8_SCHED; PG8_LDA(At, 0, 0); PG8_STAGE(PG8_SA(1, 1), a1 + hstep, voffA);
            PG8_WAIT_L(8); PG8_BAR; PG8_WAIT_L(0); PG8_MMA(0, 0, At, B0); PG8_BAR; PG8_SCHED;
            PG8_LDB(B1, 0, 1); PG8_STAGE(PG8_SB(0, 0), b2, voffB);
            PG8_BAR; PG8_WAIT_L(0); PG8_MMA(0, 1, At, B1); PG8_BAR;
            PG8_LDA(At, 0, 1); PG8_STAGE(PG8_SA(0, 0), a2, voffA);
            PG8_BAR; PG8_WAIT_L(0); PG8_MMA(1, 0, At, B0); PG8_BAR; PG8_SCHED;
            PG8_STAGE(PG8_SB(0, 1), b2 + hstep, voffB);
            PG8_WAIT_V(6); PG8_BAR; PG8_MMA(1, 1, At, B1); PG8_BAR;
            PG8_LDB(B0, 1, 0); PG8_SCHED; PG8_LDA(At, 1, 0); PG8_STAGE(PG8_SA(0, 1), a2 + hstep, voffA);
            PG8_WAIT_L(8); PG8_BAR; PG8_WAIT_L(0); PG8_MMA(0, 0, At, B0); PG8_BAR; PG8_SCHED;
            PG8_LDB(B1, 1, 1); PG8_STAGE(PG8_SB(1, 0), b3, voffB);
            PG8_BAR; PG8_WAIT_L(0); PG8_MMA(0, 1, At, B1); PG8_BAR;
            PG8_LDA(At, 1, 1); PG8_STAGE(PG8_SA(1, 0), a3, voffA);
            PG8_BAR; PG8_WAIT_L(0); PG8_MMA(1, 0, At, B0); PG8_BAR; PG8_SCHED;
            PG8_STAGE(PG8_SB(1, 1), b3 + hstep, voffB);
            PG8_WAIT_V(6); PG8_BAR; PG8_MMA(1, 1, At, B1); PG8_BAR;
        }
        PG8_STAMP();
        if constexpr (!Epi::AFTER_DRAIN) { E(acc, cur, wr, wc, fr, fq); S.done(cur); }
        PG8_STAMP();
        if (!has_next) break;
#pragma unroll
        for (int a = 0; a < 2; ++a)
#pragma unroll
            for (int b = 0; b < 2; ++b)
#pragma unroll
                for (int m = 0; m < 4; ++m)
#pragma unroll
                    for (int n = 0; n < 2; ++n) acc[a][b][m][n] = (f32x4){0.f, 0.f, 0.f, 0.f};
        cur = nxt; cA = nA; cB = nB; ++ui;
    }
    PG8_WAIT_V(0);
    if (wr == 0) PG8_BAR;
    PG8_BAR;
    if constexpr (Epi::AFTER_DRAIN) { E.fused(acc, cur, wr, wc, fr, fq, lds, wid, lane); S.done(cur); }
    PG8_STAMP();
    if (STAMP && wid == 0) { stamps[lane] = lane < nts ? (((unsigned long long)(unsigned)ts_hi << 32) | (unsigned)ts_lo) : 0ull;
        if (lane == 62) stamps[62] = rt_entry; if (lane == 63) stamps[63] = (unsigned long long)wall_clock64(); }
#undef PG8_STAMP
#undef PG8_SA
#undef PG8_SB
#undef PG8_STAGE
#undef PG8_LDA
#undef PG8_LDB
#undef PG8_MMA
#undef PG8_WAIT_V
#undef PG8_WAIT_L
#undef PG8_BAR
#undef PG8_SCHED
}
}

#ifndef MK_N_LAUNCHES
#define MK_N_LAUNCHES 1
#endif
constexpr int NPHASE = 14;
constexpr int NWAVES = 8, NTHR = 512;
constexpr int DM = 4096, NB = 4, SEQ = 2048, MTOK = NB * SEQ;
constexpr int IN_W = 8720, LDP = 8960;
constexpr int C_AQ = 0, C_AK = 2048, C_AV = 2304, C_GQ = 2560, C_GK = 3584, C_GV = 4608, C_GOUT = 6656, C_GLOW = 8704;
constexpr int NMOD = 6 * DM;
constexpr int LDK = DM + 128;
constexpr float EPS = 1e-6f;
constexpr int NEXP = 16384;
#ifndef P2_CVT_BATCHES
#define P2_CVT_BATCHES 2
#endif
constexpr int NSL = 32, SLW = 128;
__device__ __forceinline__ int pch_of(int s) { return s >= 24 ? 64 : 128; }

constexpr size_t MiB = 1u << 20;
constexpr size_t WS_CTL = 0, CTL_ZERO_BYTES = 1 * MiB;
constexpr size_t WS_ISU = 3 * MiB, WS_ISV = 3 * MiB + 65536, WS_HINV = 3 * MiB + 131072;
constexpr size_t WS_MOD = 1 * MiB, WS_KEYS = 2 * MiB, WS_WIN = 4 * MiB, WS_WOUT = 78 * MiB, WS_WQ = 112 * MiB, WS_U = 130 * MiB, WS_V = 258 * MiB;
constexpr size_t WS_H = 386 * MiB, WS_PROJ = 454 * MiB, WS_QF = 594 * MiB, WS_KF = 610 * MiB, WS_AF = 626 * MiB, WS_DL = 630 * MiB, WS_VF = 631 * MiB;
constexpr size_t WS_O = 663 * MiB, WS_CAT = 727 * MiB, WS_X1 = 795 * MiB, WS_QB = 923 * MiB, WS_PIDX = 955 * MiB, WS_GATE = 957 * MiB, WS_WT = 961 * MiB, WS_PO = 965 * MiB, WS_VT = 1029 * MiB, WS_GP = 1033 * MiB, WS_END = 1040 * MiB;
static_assert(WS_WIN + (size_t)LDP * LDK * 2 <= WS_WOUT && WS_WOUT + (size_t)DM * LDK * 2 <= WS_WQ && WS_WQ + (size_t)2048 * LDK * 2 <= WS_U && WS_H + (size_t)MTOK * LDK * 2 <= WS_PROJ && WS_CAT + (size_t)MTOK * LDK * 2 <= WS_X1, "padded operands fit their slots");
constexpr size_t WS_PART = WS_PROJ;
static_assert(WS_PART + 256 * MiB <= WS_CAT, "partials overlay");
constexpr int CW_BAR = 4096;
constexpr int CW_TRQ = 36864;
constexpr int CW_GV = 32768;
constexpr int CW_CVT = 28672;
constexpr int CW_QU = 8192, CW_QV = 12288;

constexpr int LDS_BYTES = 151552;
constexpr int MISC_OFF = 0;
constexpr int PH_OFF = 256;

#define GAS __attribute__((address_space(1)))
#define LAS __attribute__((address_space(3)))
typedef unsigned short bf16;
typedef unsigned u32x4 __attribute__((ext_vector_type(4)));
typedef unsigned u32x2 __attribute__((ext_vector_type(2)));
typedef float f32x4 __attribute__((ext_vector_type(4)));
typedef short bf16x8 __attribute__((ext_vector_type(8)));
typedef __bf16 bf16x2_t __attribute__((ext_vector_type(2)));

__device__ __forceinline__ unsigned f2bf(float f) { unsigned u = __builtin_bit_cast(unsigned, f); return (u + 0x7fffu + ((u >> 16) & 1u)) >> 16; }
__device__ __forceinline__ unsigned pk2(float lo, float hi) { unsigned r; asm volatile("v_cvt_pk_bf16_f32 %0, %1, %2" : "=v"(r) : "v"(lo), "v"(hi)); return r; }
typedef float pk2_f32x2 __attribute__((ext_vector_type(2)));
__device__ __forceinline__ unsigned pk2s(float lo, float hi) { const pk2_f32x2 t = {lo, hi}; const bf16x2_t r = __builtin_convertvector(t, bf16x2_t); return __builtin_bit_cast(unsigned, r); }
__device__ __forceinline__ float bf2f(unsigned short b) { return __builtin_bit_cast(float, (unsigned)b << 16); }
__device__ __forceinline__ float bflo(unsigned w) { return __builtin_bit_cast(float, w << 16); }
__device__ __forceinline__ float bfhi(unsigned w) { return __builtin_bit_cast(float, w & 0xffff0000u); }
__device__ __forceinline__ float wave_sum(float v) {
#pragma unroll
    for (int o = 1; o < 64; o <<= 1) v += __shfl_xor(v, o);
    return v;
}
__device__ __forceinline__ f32x4 mfma16(bf16x8 a, bf16x8 b, f32x4 c) { return __builtin_amdgcn_mfma_f32_16x16x32_bf16(a, b, c, 0, 0, 0); }
__device__ __forceinline__ float dot2bf(unsigned a, unsigned b, float c) { return __builtin_amdgcn_fdot2_f32_bf16(__builtin_bit_cast(bf16x2_t, a), __builtin_bit_cast(bf16x2_t, b), c, false); }

#define XB_TMO      128
#define XB_XCNT(j)  (256  + 64 * (j))
#define XB_XSUB(j)  (1280 + 64 * (j))
#define XB_XGEN(j)  (2304 + 64 * (j))
#define XB_TOP      3328
#define XB_TOPGEN   3392
#define XCD_BAR_WORDS 3456
#define XB_SPIN_CAP (1u << 18)

__device__ __forceinline__ unsigned xb_ld(unsigned* p)              { return __hip_atomic_load(p, __ATOMIC_RELAXED, __HIP_MEMORY_SCOPE_AGENT); }
__device__ __forceinline__ unsigned xb_add(unsigned* p, unsigned v) { return __hip_atomic_fetch_add(p, v, __ATOMIC_RELAXED, __HIP_MEMORY_SCOPE_AGENT); }
__device__ __forceinline__ unsigned xb_xcc_id() { return (unsigned)__builtin_amdgcn_s_getreg((3 << 11) | 20) & 0xFu; }
#define XB_SPIN(cond, bar) do { unsigned _sp = 0; while (cond) { __builtin_amdgcn_s_sleep(1); \
    if ((++_sp & 255u) == 0u) { if (xb_ld(&(bar)[XB_TMO])) break; if (_sp > XB_SPIN_CAP) { atomicAdd(&(bar)[XB_TMO], 1u); break; } } } } while (0)

struct XcdBarrier {
    unsigned* bar; unsigned x;
    volatile LAS unsigned* st;
};
__device__ __forceinline__ XcdBarrier xcd_barrier_post(unsigned* bar, volatile LAS unsigned* st) {
    XcdBarrier b; b.bar = bar; b.x = xb_xcc_id(); b.st = st;
    if (threadIdx.x == 0) (void)xb_add(&bar[XB_XCNT(b.x)], 1u);
    return b;
}
__device__ __forceinline__ void xcd_barrier_complete(unsigned* bar, unsigned x, unsigned& nloc, unsigned& nx) {
    const unsigned G = gridDim.x * gridDim.y * gridDim.z;
    unsigned sum, cnt, mine, sp = 0u;
    for (;;) {
        sum = 0u; cnt = 0u; mine = 0u;
#pragma unroll
        for (unsigned j = 0; j < 16; ++j) { const unsigned c = xb_ld(&bar[XB_XCNT(j)]); sum += c; cnt += (c > 0u) ? 1u : 0u; mine = (j == x) ? c : mine; }
        if (sum == G) break;
        __builtin_amdgcn_s_sleep(1);
        if ((++sp & 255u) == 0u) { if (xb_ld(&bar[XB_TMO])) break; if (sp > XB_SPIN_CAP) { atomicAdd(&bar[XB_TMO], 1u); break; } }
    }
    nloc = mine > 0u ? mine : 1u; nx = cnt > 0u ? cnt : 1u;
}
__device__ __forceinline__ void xcd_barrier(const XcdBarrier& b) {
    asm volatile("s_waitcnt vmcnt(0)" ::: "memory");
    __syncthreads();
    if (threadIdx.x == 0) {
        unsigned* bar = b.bar;
        __builtin_amdgcn_s_waitcnt(0);
        unsigned nloc = b.st[0], nx = b.st[1];
        if (nloc == 0u) { xcd_barrier_complete(bar, b.x, nloc, nx); b.st[0] = nloc; b.st[1] = nx; }
        const unsigned old = xb_add(&bar[XB_XSUB(b.x)], 1u);
        const unsigned gen = old / nloc;
        if (old + 1u == (gen + 1u) * nloc) {
            __builtin_amdgcn_fence(__ATOMIC_RELEASE, "agent");
            asm volatile("s_waitcnt vmcnt(0)" ::: "memory");
            const unsigned og = xb_add(&bar[XB_TOP], 1u);
            const unsigned tg = og / nx;
            if (og + 1u == (tg + 1u) * nx) xb_add(&bar[XB_TOPGEN], 1u);
            else XB_SPIN(xb_ld(&bar[XB_TOPGEN]) == tg, bar);
            __builtin_amdgcn_fence(__ATOMIC_ACQUIRE, "agent");
            xb_add(&bar[XB_XGEN(b.x)], 1u);
            asm volatile("s_waitcnt vmcnt(0)" ::: "memory");
        } else {
            XB_SPIN(xb_ld(&bar[XB_XGEN(b.x)]) == gen, bar);
            __builtin_amdgcn_fence(__ATOMIC_ACQUIRE, "agent");
            asm volatile("s_waitcnt vmcnt(0)" ::: "memory");
        }
    }
    __syncthreads();
}

struct Args { const float* in[18]; float* out; unsigned char* ws; int ph_lo, ph_hi, li, pad; };
struct Frame {
    LAS unsigned char* lds;
    int tid, lane, wave, G;
    const float* const* in; float* out; unsigned char* ws;
};
#define F_x        (F.in[0])
#define F_c        (F.in[1])
#define F_w_ada    (F.in[2])
#define F_b_ada    (F.in[3])
#define F_norm1_g  (F.in[4])
#define F_norm2_g  (F.in[5])
#define F_w_in     (F.in[6])
#define F_sinks    (F.in[7])
#define F_rel_bias (F.in[8])
#define F_gk2_w    (F.in[9])
#define F_gk2_b    (F.in[10])
#define F_gla_g    (F.in[11])
#define F_w_out    (F.in[12])
#define F_peer_wq  (F.in[13])
#define F_peer_keys (F.in[14])
#define F_peer_u   (F.in[15])
#define F_peer_v   (F.in[16])
#define F_final_g  (F.in[17])
#define F_out      (F.out)
#define F_mod      ((float*)(F.ws + WS_MOD))
#define F_keysb    ((bf16*)(F.ws + WS_KEYS))
#define F_win_t    ((bf16*)(F.ws + WS_WIN))
#define F_wout_t   ((bf16*)(F.ws + WS_WOUT))
#define F_wq_t     ((bf16*)(F.ws + WS_WQ))
#define F_ub       ((bf16*)(F.ws + WS_U))
#define F_vb       ((bf16*)(F.ws + WS_V))
#define F_hb       ((bf16*)(F.ws + WS_H))
#define F_proj     ((bf16*)(F.ws + WS_PROJ))
#define F_qf       ((bf16*)(F.ws + WS_QF))
#define F_kf       ((bf16*)(F.ws + WS_KF))
#define F_af       ((bf16*)(F.ws + WS_AF))
#define F_dl       ((float*)(F.ws + WS_DL))
#define F_vf       ((bf16*)(F.ws + WS_VF))
#define F_obuf     ((bf16*)(F.ws + WS_O))
#define F_cat      ((bf16*)(F.ws + WS_CAT))
#define F_x1       ((bf16*)(F.ws + WS_X1))
#define F_qb       ((bf16*)(F.ws + WS_QB))
#define F_sk       ((unsigned*)(F.ws + WS_O))
#define F_pidx     ((unsigned short*)(F.ws + WS_PIDX))
#define F_gate     ((float*)(F.ws + WS_GATE))
#define F_wq       ((unsigned char*)(F.ws + WS_WT))
#define F_wsc      ((float*)(F.ws + WS_WT + 2 * MiB))
#define F_po       ((bf16*)(F.ws + WS_PO))
#define F_part     ((bf16*)(F.ws + WS_PART))
#define F_vt       ((bf16*)(F.ws + WS_VT))
#define F_u8       ((unsigned char*)(F.ws + WS_U))
#define F_v8       ((unsigned char*)(F.ws + WS_V))
#define F_isu      ((float*)(F.ws + WS_ISU))
#define F_isv      ((float*)(F.ws + WS_ISV))
#define F_hinv     ((float*)(F.ws + WS_HINV))
#define F_h8       ((unsigned char*)(F.ws + WS_QF))


#define LAUNDER_IDS(F) do { int t_ = (F).tid, w_ = (F).wave; asm volatile("" : "+v"(t_), "+s"(w_)); (F).tid = t_; (F).lane = t_ & 63; (F).wave = w_; } while (0)
__device__ __forceinline__ void p0_transpose_item(const float* W, int ldw, int K, int src_c0, bf16* WT, int dst_r0, int k0, LAS float* scr, int lane) {
#pragma unroll 8
    for (int i = 0; i < 32; ++i) { const int kk = 2 * i + (lane >> 5); scr[kk * 33 + (lane & 31)] = W[(size_t)(k0 + kk) * ldw + src_c0 + (lane & 31)]; }
    asm volatile("s_waitcnt lgkmcnt(0)" ::: "memory");
    const int c = lane & 7;
#pragma unroll
    for (int j = 0; j < 4; ++j) { const int n = (lane >> 3) + 8 * j; const LAS float* s = scr + (8 * c) * 33 + n;
        u32x4 o; o.x = pk2(s[0 * 33], s[1 * 33]); o.y = pk2(s[2 * 33], s[3 * 33]); o.z = pk2(s[4 * 33], s[5 * 33]); o.w = pk2(s[6 * 33], s[7 * 33]);
        *(u32x4*)(WT + (size_t)(dst_r0 + n) * K + k0 + 8 * c) = o; }
    asm volatile("s_waitcnt lgkmcnt(0)" ::: "memory");
}
__device__ __forceinline__ void cvt_rows(const float* src, bf16* dst, size_t n8, size_t i0, size_t stride) {
    for (size_t i = i0; i < n8; i += stride) { const f32x4 a = *(const f32x4*)(src + 8 * i), b = *(const f32x4*)(src + 8 * i + 4);
        u32x4 o; o.x = pk2(a.x, a.y); o.y = pk2(a.z, a.w); o.z = pk2(b.x, b.y); o.w = pk2(b.z, b.w); *(u32x4*)(dst + 8 * i) = o; }
}
__device__ __forceinline__ unsigned q8x4(f32x4 x) { const int a = (int)__builtin_rintf(x.x), b = (int)__builtin_rintf(x.y), c = (int)__builtin_rintf(x.z), d = (int)__builtin_rintf(x.w);
    return (unsigned)(a & 255) | ((unsigned)(b & 255) << 8) | ((unsigned)(c & 255) << 16) | ((unsigned)d << 24); }
template <bool I8> __device__ __forceinline__ void cvt_fp8_row(const float* src, unsigned char* dst, float* isc, int e, int lane) {
    const f32x4* sp = (const f32x4*)(src + (size_t)e * DM) + lane * 4;
    f32x4 v[16]; float am = 0.f;
#pragma unroll
    for (int m = 0; m < 4; ++m)
#pragma unroll
        for (int i = 0; i < 4; ++i) { v[m * 4 + i] = sp[m * 256 + i]; const f32x4 x = v[m * 4 + i]; am = fmaxf(am, fmaxf(fmaxf(fabsf(x.x), fabsf(x.y)), fmaxf(fabsf(x.z), fabsf(x.w)))); }
#pragma unroll
    for (int o = 1; o < 64; o <<= 1) am = fmaxf(am, __shfl_xor(am, o));
    const float top = I8 ? 127.f : 384.f;
    const float sc = am > 0.f ? top / am : 1.f;
    if (lane == 0) isc[e] = am > 0.f ? am / top : 1.f;
#pragma unroll
    for (int m = 0; m < 4; ++m) { u32x4 o; unsigned ow[4];
#pragma unroll
        for (int i = 0; i < 4; ++i) { const f32x4 x = v[m * 4 + i] * sc;
            if (I8) ow[i] = q8x4(x);
            else { int pk = 0; pk = __builtin_amdgcn_cvt_pk_fp8_f32(x.x, x.y, pk, false); pk = __builtin_amdgcn_cvt_pk_fp8_f32(x.z, x.w, pk, true); ow[i] = (unsigned)pk; } }
        o.x = ow[0]; o.y = ow[1]; o.z = ow[2]; o.w = ow[3];
        *(u32x4*)(dst + ((size_t)(8 * m + (lane >> 3)) * NEXP + e) * SLW + (lane & 7) * 16) = o; }
}
__device__ __forceinline__ void cvt_u4_row(const float* src, unsigned char* dst, float* isc, int e, int lane) {
    const f32x4* sp = (const f32x4*)(src + (size_t)e * DM) + lane * 4;
    f32x4 v[16]; float am = 0.f;
#pragma unroll
    for (int m = 0; m < 4; ++m)
#pragma unroll
        for (int i = 0; i < 4; ++i) { v[m * 4 + i] = sp[m * 256 + i]; const f32x4 x = v[m * 4 + i]; am = fmaxf(am, fmaxf(fmaxf(fabsf(x.x), fabsf(x.y)), fmaxf(fabsf(x.z), fabsf(x.w)))); }
#pragma unroll
    for (int o = 1; o < 64; o <<= 1) am = fmaxf(am, __shfl_xor(am, o));
    const float sc = am > 0.f ? 7.5f / am : 1.f;
    if (lane == 0) isc[e] = am > 0.f ? am * (1.f / 7.5f) : 1.f;
#pragma unroll
    for (int m = 0; m < 4; ++m) { unsigned nb[16];
#pragma unroll
        for (int i = 0; i < 4; ++i) { const f32x4 x = v[m * 4 + i] * sc + 8.f;
            const unsigned n0 = (unsigned)__builtin_fminf(__builtin_fmaxf(__builtin_floorf(x.x), 0.f), 15.f), n1 = (unsigned)__builtin_fminf(__builtin_fmaxf(__builtin_floorf(x.y), 0.f), 15.f);
            const unsigned n2 = (unsigned)__builtin_fminf(__builtin_fmaxf(__builtin_floorf(x.z), 0.f), 15.f), n3 = (unsigned)__builtin_fminf(__builtin_fmaxf(__builtin_floorf(x.w), 0.f), 15.f);
            nb[4 * i + 0] = n0 ^ 8u; nb[4 * i + 1] = n1 ^ 8u; nb[4 * i + 2] = n2 ^ 8u; nb[4 * i + 3] = n3 ^ 8u; }
        u32x2 o; o.x = 0u; o.y = 0u;
#pragma unroll
        for (int j = 0; j < 8; ++j) o.x |= nb[j] << (4 * j);
#pragma unroll
        for (int j = 0; j < 8; ++j) o.y |= nb[8 + j] << (4 * j);
        *(u32x2*)(dst + ((size_t)(4 * m + (lane >> 4)) * NEXP + e) * 128 + 8 * (lane & 15)) = o; }
}
__device__ __forceinline__ void cvt_pull(Frame& F, unsigned* head, int max_batches) {
    for (int nb = 0; nb < max_batches; ++nb) {
        unsigned h = 0u; if (F.lane == 0) h = __hip_atomic_fetch_add(head, 1u, __ATOMIC_RELAXED, __HIP_MEMORY_SCOPE_AGENT);
        h = (unsigned)__builtin_amdgcn_readfirstlane((int)h);
        if (h >= 4096u) break;
#pragma unroll 1
        for (int r = 0; r < 8; ++r) { const int row = (int)h * 8 + r;
            if (row < NEXP) cvt_u4_row(F_peer_u, F_u8, F_isu, row, F.lane); else cvt_fp8_row<true>(F_peer_v, F_v8, F_isv, row - NEXP, F.lane); }
    }
}
__device__ __forceinline__ void p0_prologue(Frame& F) {
    const int tid = F.tid, lane = F.lane, wave = F.wave;
    if (F.G == 256) {
        LAS float* sc = (LAS float*)(F.lds + PH_OFF);
        volatile LAS int* qw = (volatile LAS int*)(F.lds + MISC_OFF + 64);
        const int cg = blockIdx.x & 15, kq = blockIdx.x >> 4;
        for (int i = tid; i < 4 * 256; i += NTHR) { const float v = F_c[(i >> 8) * DM + 256 * kq + (i & 255)]; sc[i] = v / (1.f + __expf(-v)); }
        __syncthreads();
        float* gp = (float*)(F.ws + WS_GP);
        if (tid < 384) {
            f32x4 acc[4];
#pragma unroll
            for (int b = 0; b < 4; ++b) acc[b] = (f32x4){0.f, 0.f, 0.f, 0.f};
            const float* wp = F_w_ada + (size_t)(256 * kq) * NMOD + 1536 * cg + 4 * tid;
#pragma unroll 8
            for (int k = 0; k < 256; ++k) { const f32x4 w = *(const f32x4*)wp; wp += NMOD;
#pragma unroll
                for (int b = 0; b < 4; ++b) acc[b] += w * sc[b * 256 + k]; }
#pragma unroll
            for (int b = 0; b < 4; ++b) *(f32x4*)(gp + ((size_t)kq * 4 + b) * NMOD + 1536 * cg + 4 * tid) = acc[b];
        }
        asm volatile("s_waitcnt vmcnt(0)" ::: "memory");
        __syncthreads();
        if (tid == 0) { __builtin_amdgcn_fence(__ATOMIC_RELEASE, "agent"); asm volatile("s_waitcnt vmcnt(0)" ::: "memory");
            const unsigned old = __hip_atomic_fetch_add((unsigned*)(F.ws + WS_CTL) + CW_GV + 64 * cg, 1u, __ATOMIC_RELAXED, __HIP_MEMORY_SCOPE_AGENT);
            if (old == 15u) { __builtin_amdgcn_fence(__ATOMIC_ACQUIRE, "agent"); asm volatile("s_waitcnt vmcnt(0)" ::: "memory"); }
            qw[0] = (int)old; }
        __syncthreads();
        if (qw[0] == 15) {
            for (int o = tid; o < 4 * 384; o += NTHR) { const int b = o / 384, c4 = o % 384; const size_t col = (size_t)1536 * cg + 4 * c4;
                f32x4 sum = *(const f32x4*)(F_b_ada + col);
#pragma unroll 4
                for (int k2 = 0; k2 < 16; ++k2) sum += *(const f32x4*)(gp + ((size_t)k2 * 4 + b) * NMOD + col);
                *(f32x4*)(F_mod + (size_t)b * NMOD + col) = sum; }
        }
        __syncthreads();
    } else
    {
        LAS float* sc = (LAS float*)(F.lds + PH_OFF);
        LAS float* red = sc + 4 * DM;
        for (int i = tid; i < 4 * DM; i += NTHR) { const float v = F_c[i]; sc[i] = v / (1.f + __expf(-v)); }
        __syncthreads();
        for (int slab = blockIdx.x; slab < NMOD / 96; slab += F.G) {
            const int cg = tid % 24, kg = tid / 24;
            if (kg < 21) {
                f32x4 acc[4];
#pragma unroll
                for (int b = 0; b < 4; ++b) acc[b] = (f32x4){0.f, 0.f, 0.f, 0.f};
                const float* wp = F_w_ada + (size_t)kg * NMOD + slab * 96 + cg * 4;
#pragma unroll 4
                for (int k = kg; k < DM; k += 21) { const f32x4 w = *(const f32x4*)wp; wp += (size_t)21 * NMOD;
#pragma unroll
                    for (int b = 0; b < 4; ++b) acc[b] += w * sc[b * DM + k]; }
#pragma unroll
                for (int b = 0; b < 4; ++b) *(LAS f32x4*)(red + (kg * 4 + b) * 96 + cg * 4) = acc[b];
            }
            __syncthreads();
            if (tid < 384) { const int b = tid / 96, col = tid % 96; float s = F_b_ada[slab * 96 + col];
                for (int kg2 = 0; kg2 < 21; ++kg2) s += red[(kg2 * 4 + b) * 96 + col];
                F_mod[b * NMOD + slab * 96 + col] = s; }
            __syncthreads();
        }
    }
    {
        LAS float* scr = (LAS float*)(F.lds + PH_OFF + wave * 8448);
        const int gw = blockIdx.x * NWAVES + wave, NGW = F.G * NWAVES;
        constexpr int I_IN = 64 * 272;
        for (int it = gw; it < I_IN; it += NGW) { const int kb = it / 272, nb = it % 272, r0 = nb * 32; p0_transpose_item(F_w_in, IN_W, LDK, r0 < 6656 ? r0 : r0 + 16, F_win_t, r0, kb * 64, scr, lane); }
        const size_t gt = (size_t)blockIdx.x * NTHR + tid, NT = (size_t)F.G * NTHR;
        for (size_t i = gt; i < (size_t)256 * DM / 8; i += NT) { const int row = (int)(i / (DM / 8)), kc = (int)(i % (DM / 8)) * 8;
            u32x4 o = {0u, 0u, 0u, 0u};
            if (row < 16) { float v[8];
#pragma unroll
                for (int j = 0; j < 8; ++j) v[j] = F_w_in[(size_t)(kc + j) * IN_W + 6656 + row];
                o.x = pk2(v[0], v[1]); o.y = pk2(v[2], v[3]); o.z = pk2(v[4], v[5]); o.w = pk2(v[6], v[7]); }
            *(u32x4*)(F_win_t + (size_t)(8704 + row) * LDK + kc) = o; }
    }
}
__device__ __forceinline__ void swa_block_item(Frame& F, int item);
__device__ __forceinline__ bf16x8 ld8_bf16(const float* p) { const f32x4 a = *(const f32x4*)p, b = *(const f32x4*)(p + 4); u32x4 o; o.x = pk2(a.x, a.y); o.y = pk2(a.z, a.w); o.z = pk2(b.x, b.y); o.w = pk2(b.z, b.w); return __builtin_bit_cast(bf16x8, o); }
__device__ __forceinline__ void fold_keys_task(Frame& F, int ft) {
    const int lane = F.lane, g = lane >> 4, n = lane & 15, hp = ft >> 6, D0 = (ft & 63) * 64;
    bf16x8 af[4][4];
#pragma unroll
    for (int dt = 0; dt < 4; ++dt)
#pragma unroll
        for (int ks = 0; ks < 4; ++ks) af[dt][ks] = ld8_bf16(F_peer_wq + (size_t)(D0 + 16 * dt + n) * 2048 + hp * 128 + 32 * ks + 8 * g);
#pragma unroll 1
    for (int kt0 = 0; kt0 < 8; kt0 += 4) {
        bf16x8 bfr[4][4];
#pragma unroll
        for (int kq = 0; kq < 4; ++kq)
#pragma unroll
            for (int ks = 0; ks < 4; ++ks) bfr[kq][ks] = ld8_bf16(F_peer_keys + ((size_t)hp * 128 + 16 * (kt0 + kq) + n) * 128 + 32 * ks + 8 * g);
#pragma unroll
        for (int kq = 0; kq < 4; ++kq)
#pragma unroll
            for (int dt = 0; dt < 4; ++dt) { f32x4 acc = {0.f, 0.f, 0.f, 0.f};
#pragma unroll
                for (int ks = 0; ks < 4; ++ks) acc = mfma16(af[dt][ks], bfr[kq][ks], acc);
                u32x2 o; o.x = pk2s(acc[0], acc[1]); o.y = pk2s(acc[2], acc[3]);
                *(u32x2*)(F_wq_t + (size_t)(hp * 128 + 16 * (kt0 + kq) + n) * LDK + D0 + 16 * dt + 4 * g) = o; }
    }
}
__device__ __forceinline__ void trans_pull(Frame& F, LAS float* scr) {
    constexpr int I_OUT = 64 * 128, I_Q = 64 * 64, NBATCH = (I_OUT + I_Q) / 4;
    unsigned* head = (unsigned*)(F.ws + WS_CTL) + CW_TRQ;
    for (;;) {
        unsigned hq = 0u; if (F.lane == 0) hq = __hip_atomic_fetch_add(head, 1u, __ATOMIC_RELAXED, __HIP_MEMORY_SCOPE_AGENT);
        hq = (unsigned)__builtin_amdgcn_readfirstlane((int)hq);
        if (hq >= (unsigned)NBATCH) break;
        if ((int)hq >= I_OUT / 4) { fold_keys_task(F, (int)hq - I_OUT / 4); continue; }
#pragma unroll 1
        for (int j = 0; j < 4; ++j) { const int it = (int)hq * 4 + j; const int kb = it / 128, nb = it % 128; p0_transpose_item(F_w_out, DM, LDK, nb * 32, F_wout_t, nb * 32, kb * 64, scr, F.lane); }
    }
}
__device__ __forceinline__ void p4_side(Frame& F, int sb, int nsb) {
    for (int item = sb; item < NB * 2 * 16; item += nsb) swa_block_item(F, item);
    LAUNDER_IDS(F);
    trans_pull(F, (LAS float*)(F.lds + PH_OFF + F.wave * 8448));
    cvt_pull(F, (unsigned*)(F.ws + WS_CTL) + CW_CVT, 1 << 20);
}

template <bool IN16, bool Q8> __device__ __forceinline__ void norm_mod_phase(Frame& F, const void* xin, const float* g, int shift_off, int scale_off, bf16* outp) {
    const int gw = blockIdx.x * NWAVES + F.wave, NGW = F.G * NWAVES, lane = F.lane;
    for (int row = gw; row < MTOK; row += NGW) {
        const int b = row / SEQ;
        f32x4 v[16]; float ss = 0.f;
        if (IN16) { const u32x2* xr = (const u32x2*)((const bf16*)xin + (size_t)row * DM) + lane;
#pragma unroll
            for (int j = 0; j < 16; ++j) { const u32x2 t = xr[64 * j]; v[j] = (f32x4){bflo(t.x), bfhi(t.x), bflo(t.y), bfhi(t.y)}; }
        } else { const f32x4* xr = (const f32x4*)((const float*)xin + (size_t)row * DM) + lane;
#pragma unroll
            for (int j = 0; j < 16; ++j) v[j] = xr[64 * j]; }
#pragma unroll
        for (int j = 0; j < 16; ++j) ss += (v[j].x * v[j].x + v[j].y * v[j].y) + (v[j].z * v[j].z + v[j].w * v[j].w);
        const float rstd = rsqrtf(wave_sum(ss) * (1.f / DM) + EPS);
        const float* mb = F_mod + (size_t)b * NMOD;
        u32x2* op = (u32x2*)(outp + (size_t)row * LDK) + lane;
        float am = 0.f;
#pragma unroll
        for (int j = 0; j < 16; ++j) { const int col = (lane + 64 * j) * 4;
            const f32x4 gv = *(const f32x4*)(g + col), sc = *(const f32x4*)(mb + scale_off + col), sh = *(const f32x4*)(mb + shift_off + col);
            const f32x4 y = (v[j] * rstd) * gv * (sc + 1.f) + sh;
            u32x2 o; o.x = pk2(y.x, y.y); o.y = pk2(y.z, y.w); op[64 * j] = o;
            if (Q8) { v[j] = y; am = fmaxf(am, fmaxf(fmaxf(fabsf(y.x), fabsf(y.y)), fmaxf(fabsf(y.z), fabsf(y.w)))); } }
        if (Q8) {
#pragma unroll
            for (int o2 = 1; o2 < 64; o2 <<= 1) am = fmaxf(am, __shfl_xor(am, o2));
            const float S = am > 0.f ? 119.f / am : 1.f;
            if (lane == 0) F_hinv[row] = am > 0.f ? am * (1.f / 119.f) : 1.f;
            unsigned* hph = (unsigned*)(F_h8 + (size_t)row * 2048) + (lane >> 1);
            unsigned* hpl = (unsigned*)(F_h8 + (size_t)MTOK * 2048 + (size_t)row * 2048) + (lane >> 1);
#pragma unroll
            for (int j = 0; j < 16; ++j) { const unsigned x = q8x4(v[j] * S);
                const unsigned t2 = (x ^ 0x80808080u) + 0x08080808u;
                const unsigned HI = ((t2 >> 4) & 0x0F0F0F0Fu) ^ 0x08080808u, LO = (t2 & 0x0F0F0F0Fu) ^ 0x08080808u;
                const unsigned yh = HI | (HI >> 4), yl = LO | (LO >> 4);
                const unsigned ch = __builtin_amdgcn_perm(yh, yh, 0x00000200u) & 0xFFFFu, cl = __builtin_amdgcn_perm(yl, yl, 0x00000200u) & 0xFFFFu;
                const unsigned ph = (unsigned)__builtin_amdgcn_update_dpp(0, (int)ch, 0xB1, 0xf, 0xf, true), pl = (unsigned)__builtin_amdgcn_update_dpp(0, (int)cl, 0xB1, 0xf, 0xf, true);
                if (!(lane & 1)) { hph[32 * j] = ch | (ph << 16); hpl[32 * j] = cl | (pl << 16); } }
        }
    }
}

__device__ __forceinline__ int t5_bucket(int d) {
    if (d < 16) return d;
    const int v = 16 + (int)(__log2f((float)d * (1.f / 16.f)) * (16.f / 3.f));
    return v < 31 ? v : 31;
}
constexpr int KS_LDK = 136, VT_LD = 296;
__device__ __forceinline__ void swa_block_item(Frame& F, int item) {
    const int tid = F.tid, lane = F.lane, w = F.wave, g = lane >> 4, r = lane & 15;
    const int n = item & 15, kvh = (item >> 4) & 1, b = item >> 5;
    LAS unsigned short* Ks = (LAS unsigned short*)(F.lds + PH_OFF);
    LAS unsigned short* Vt = Ks + 256 * KS_LDK;
    LAS float* btab = (LAS float*)(Vt + 128 * VT_LD);
    const int tok0 = b * SEQ + n * 128, tokmin = b * SEQ;
    __syncthreads();
    {
        const int kr = tid >> 4, kc = tid & 15;
        LAS unsigned char* kl = (LAS unsigned char*)Ks + kr * (KS_LDK * 2) + 16 * kc;
        const int r0 = (n == 0) ? tokmin + kr : tok0 - 128 + kr;
        const unsigned char* kg0 = (const unsigned char*)(F_proj + (size_t)r0 * LDP + C_AK + kvh * 128 + 8 * kc);
        const unsigned char* kg1 = (const unsigned char*)(F_proj + (size_t)(tok0 + kr) * LDP + C_AK + kvh * 128 + 8 * kc);
        u32x4 kv[8];
#pragma unroll
        for (int j = 0; j < 4; ++j) { kv[j] = *(const u32x4*)(kg0 + (size_t)j * (32 * LDP * 2)); kv[4 + j] = *(const u32x4*)(kg1 + (size_t)j * (32 * LDP * 2)); }
#pragma unroll
        for (int j = 0; j < 8; ++j) *(LAS u32x4*)(kl + j * (32 * KS_LDK * 2)) = kv[j];
        const int vr = tid >> 5, vc = tid & 31;
        LAS unsigned char* vl = (LAS unsigned char*)Vt + vr * (VT_LD * 2) + 16 * vc;
        const int tcol = (n == 0 && vc < 16) ? tokmin + 8 * vc : tok0 - 128 + 8 * vc;
        const unsigned char* vg = (const unsigned char*)(F_vt + (size_t)(kvh * 128 + vr) * MTOK + tcol);
#pragma unroll
        for (int j = 0; j < 8; ++j) kv[j] = *(const u32x4*)(vg + (size_t)j * (16 * MTOK * 2));
#pragma unroll
        for (int j = 0; j < 8; ++j) *(LAS u32x4*)(vl + j * (16 * VT_LD * 2)) = kv[j];
    }
    for (int idx = tid; idx < 128 * 5; idx += NTHR) *(LAS u32x4*)(Vt + (idx / 5) * VT_LD + 256 + 8 * (idx % 5)) = (u32x4){0u, 0u, 0u, 0u};
    for (int idx = tid; idx < 8 * 128; idx += NTHR) btab[idx] = F_rel_bias[t5_bucket(idx & 127) * 16 + kvh * 8 + (idx >> 7)];
    __syncthreads();
    constexpr float SCALE = 0.08838834764831845f;
    const int lb = 4 * g + 16 * w - (n == 0 ? 128 : 0), lrel = 4 * g - r;
    bf16x8 qnx[4];
    { const bf16* qp = F_proj + (size_t)(tok0 + 16 * w + r) * LDP + C_AQ + (kvh * 8) * 128 + 8 * g;
#pragma unroll
      for (int ks = 0; ks < 4; ++ks) qnx[ks] = *(const bf16x8*)(qp + 32 * ks); }
#pragma unroll 1
    for (int hh = 0; hh < 8; ++hh) {
        const int h = kvh * 8 + hh;
        bf16x8 qfr[4];
#pragma unroll
        for (int ks = 0; ks < 4; ++ks) qfr[ks] = qnx[ks];
        { const bf16* qp = F_proj + (size_t)(tok0 + 16 * w + r) * LDP + C_AQ + (kvh * 8 + (hh < 7 ? hh + 1 : 7)) * 128 + 8 * g;
#pragma unroll
          for (int ks = 0; ks < 4; ++ks) qnx[ks] = *(const bf16x8*)(qp + 32 * ks); }
        float sc[9][4];
#pragma unroll
        for (int t = 0; t < 9; ++t) {
            const LAS unsigned short* kp = Ks + (16 * (w + t) + r) * KS_LDK + 8 * g;
            f32x4 acc0 = {0.f, 0.f, 0.f, 0.f};
#pragma unroll
            for (int ks = 0; ks < 4; ++ks) acc0 = mfma16(*(const LAS bf16x8*)(kp + 32 * ks), qfr[ks], acc0);
#pragma unroll
            for (int reg = 0; reg < 4; ++reg) { const int rel = lrel + 16 * t + reg;
                const bool ok = (rel > 0) && (rel <= 128) && (lb + 16 * t + reg >= 0);
                sc[t][reg] = ok ? acc0[reg] * SCALE + btab[hh * 128 + ((128 - rel) & 127)] : -1e30f; }
        }
        const float sink = F_sinks[h];
        float m = sink;
#pragma unroll
        for (int t = 0; t < 9; ++t)
#pragma unroll
            for (int reg = 0; reg < 4; ++reg) m = fmaxf(m, sc[t][reg]);
        m = fmaxf(m, __shfl_xor(m, 16)); m = fmaxf(m, __shfl_xor(m, 32));
        float sum = 0.f;
#pragma unroll
        for (int t = 0; t < 9; ++t)
#pragma unroll
            for (int reg = 0; reg < 4; ++reg) { sc[t][reg] = __expf(sc[t][reg] - m); sum += sc[t][reg]; }
        sum += __shfl_xor(sum, 16); sum += __shfl_xor(sum, 32);
        const float inv = 1.f / (sum + __expf(sink - m));
        f32x4 o[8];
#pragma unroll
        for (int dt = 0; dt < 8; ++dt) o[dt] = (f32x4){0.f, 0.f, 0.f, 0.f};
#pragma unroll
        for (int s5 = 0; s5 < 5; ++s5) {
            u32x4 pw; pw.x = pk2(sc[2 * s5][0], sc[2 * s5][1]); pw.y = pk2(sc[2 * s5][2], sc[2 * s5][3]);
            if (2 * s5 + 1 < 9) { pw.z = pk2(sc[(2 * s5 + 1) % 9][0], sc[(2 * s5 + 1) % 9][1]); pw.w = pk2(sc[(2 * s5 + 1) % 9][2], sc[(2 * s5 + 1) % 9][3]); } else { pw.z = 0u; pw.w = 0u; }
            const bf16x8 pf = __builtin_bit_cast(bf16x8, pw);
            const LAS unsigned short* vp0 = Vt + r * VT_LD + 16 * w + 32 * s5 + 4 * g;
#pragma unroll
            for (int dt = 0; dt < 8; ++dt) { const LAS unsigned short* vp = vp0 + (16 * dt) * VT_LD;
                const u32x2 lo = *(const LAS u32x2*)vp, hi = *(const LAS u32x2*)(vp + 16);
                u32x4 va; va.x = lo.x; va.y = lo.y; va.z = hi.x; va.w = hi.y;
                o[dt] = mfma16(__builtin_bit_cast(bf16x8, va), pf, o[dt]); }
        }
        bf16* op = F_cat + (size_t)(tok0 + 16 * w + r) * LDK + h * 128 + 4 * g;
#pragma unroll
        for (int dt = 0; dt < 8; ++dt) { u32x2 ov; ov.x = pk2(o[dt][0] * inv, o[dt][1] * inv); ov.y = pk2(o[dt][2] * inv, o[dt][3] * inv); *(u32x2*)(op + 16 * dt) = ov; }
    }
    __syncthreads();
}

constexpr int QD_LD = 264, VS_LD = 520;
__device__ __forceinline__ void gla_prep_item(Frame& F, int item) {
    const int tid = F.tid, lane = F.lane, w = F.wave, g = lane >> 4, r = lane & 15;
    const int n = item & 31, h = (item >> 5) & 3, b = item >> 7;
    const int tok0 = b * SEQ + n * 64;
    LAS float* glw = (LAS float*)(F.lds + PH_OFF);
    LAS float* bc = glw + 1024;
    LAS unsigned* pk = (LAS unsigned*)bc;
    LAS unsigned short* qd = (LAS unsigned short*)(bc + 64 * 256);
    LAS unsigned short* ki = qd + 64 * QD_LD;
    LAS unsigned short* vs = qd;
    for (int idx = tid; idx < 1024; idx += NTHR) glw[idx] = bf2f(F_proj[(size_t)(tok0 + (idx >> 4)) * LDP + C_GLOW + (idx & 15)]);
    __syncthreads();
    const int d = tid & 255, half = tid >> 8;
    {
        float wv[16];
#pragma unroll
        for (int q = 0; q < 16; ++q) wv[q] = F_gk2_w[q * 1024 + h * 256 + d];
        const float bias = F_gk2_b[h * 256 + d];
        float run = 0.f;
        for (int tt = 0; tt < 32; ++tt) { const int t = half * 32 + tt; float z = bias;
#pragma unroll
            for (int q = 0; q < 16; ++q) z += glw[t * 16 + q] * wv[q];
            const float ls = fminf(z, 0.f) - log1pf(__expf(-fabsf(z)));
            run += ls * (1.f / 16.f); bc[t * 256 + d] = run; }
    }
    __syncthreads();
    {
        const float off = half ? bc[31 * 256 + d] : 0.f;
        const float blast = bc[63 * 256 + d] + bc[31 * 256 + d];
        __syncthreads();
        const bf16* qg = F_proj + (size_t)tok0 * LDP + C_GQ + h * 256 + d;
#pragma unroll 4
        for (int tt = 0; tt < 32; ++tt) { const int t = half * 32 + tt; const float bt = bc[t * 256 + d] + off;
            const float q = bf2f(qg[(size_t)t * LDP]), k = bf2f(qg[(size_t)t * LDP + (C_GK - C_GQ)]);
            const float qdv = q * (1.f / 16.f) * __expf(bt), kiv = k * __expf(-bt), kdv = k * __expf(blast - bt);
            const unsigned qb16 = f2bf(qdv);
            qd[t * QD_LD + d] = (unsigned short)qb16; ki[t * QD_LD + d] = (unsigned short)f2bf(kiv);
            pk[t * 256 + d] = qb16 | (f2bf(kdv) << 16); }
        if (half == 0) F_dl[(size_t)item * 256 + d] = __expf(blast);
    }
    __syncthreads();
    {
        bf16* qfp = F_qf + (size_t)item * 16384; bf16* kfp = F_kf + (size_t)item * 16384;
#pragma unroll
        for (int j4 = 0; j4 < 4; ++j4) { const int pc = tid + 512 * j4, fl = pc & 63, fr = pc >> 6, fg = fl >> 4, fi = fl & 15;
            { const int T = fr >> 2, tt = fr & 3, t = 16 * tt + fi;
              const u32x2 lo = *(const LAS u32x2*)(qd + t * QD_LD + 32 * T + 4 * fg), hi = *(const LAS u32x2*)(qd + t * QD_LD + 32 * T + 16 + 4 * fg);
              u32x4 o; o.x = lo.x; o.y = lo.y; o.z = hi.x; o.w = hi.y; *(u32x4*)(qfp + (size_t)pc * 8) = o; }
            { const int dkt = fr >> 1, ks = fr & 1;
              const LAS unsigned* kp = pk + (32 * ks + 8 * fg) * 256 + 16 * dkt + fi;
              u32x4 o; o.x = (kp[0] >> 16) | (kp[256] & 0xffff0000u); o.y = (kp[512] >> 16) | (kp[768] & 0xffff0000u); o.z = (kp[1024] >> 16) | (kp[1280] & 0xffff0000u); o.w = (kp[1536] >> 16) | (kp[1792] & 0xffff0000u);
              *(u32x4*)(kfp + (size_t)pc * 8) = o; } }
        bf16* afp = F_af + (size_t)item * 4096;
        for (int tile = w; tile < 16; tile += 8) { const int ti = tile >> 2, tj = tile & 3;
            f32x4 acc = {0.f, 0.f, 0.f, 0.f};
            if (tj <= ti) {
#pragma unroll
                for (int ks = 0; ks < 8; ++ks) acc = mfma16(*(const LAS bf16x8*)(qd + (16 * ti + r) * QD_LD + 32 * ks + 8 * g), *(const LAS bf16x8*)(ki + (16 * tj + r) * QD_LD + 32 * ks + 8 * g), acc); }
#pragma unroll
            for (int reg = 0; reg < 4; ++reg) { const int row = 16 * ti + 4 * g + reg, col = 16 * tj + r;
                const float val = (tj <= ti && row >= col) ? acc[reg] : 0.f;
                afp[(((row >> 4) * 2 + (col >> 5)) * 64 + ((col & 31) >> 3) * 16 + (row & 15)) * 8 + (col & 7)] = (unsigned short)f2bf(val); }
        }
    }
    __syncthreads();
    {
#pragma unroll
        for (int j8 = 0; j8 < 8; ++j8) { const int idx = tid + 512 * j8, t = idx >> 6, c = idx & 63;
            *(LAS u32x4*)(vs + t * VS_LD + 8 * c) = *(const u32x4*)(F_proj + (size_t)(tok0 + t) * LDP + C_GV + h * 512 + 8 * c); }
        __syncthreads();
        bf16* vfp = F_vf + (size_t)item * 32768;
#pragma unroll
        for (int j8 = 0; j8 < 8; ++j8) { const int pc = tid + 512 * j8, fl = pc & 63, fr = pc >> 6, fg = fl >> 4, fi = fl & 15, dvt = fr >> 1, ks = fr & 1;
            const LAS unsigned short* vp = vs + (32 * ks + 8 * fg) * VS_LD + 16 * dvt + fi;
            u32x4 o; o.x = (unsigned)vp[0] | ((unsigned)vp[VS_LD] << 16); o.y = (unsigned)vp[2 * VS_LD] | ((unsigned)vp[3 * VS_LD] << 16); o.z = (unsigned)vp[4 * VS_LD] | ((unsigned)vp[5 * VS_LD] << 16); o.w = (unsigned)vp[6 * VS_LD] | ((unsigned)vp[7 * VS_LD] << 16);
            *(u32x4*)(vfp + (size_t)pc * 8) = o; }
    }
    __syncthreads();
}

constexpr int SCA_BYTES = 57344, SCB_BYTES = 33792;
#define SC_BAR() asm volatile("s_waitcnt lgkmcnt(0)\n\ts_barrier" ::: "memory")
__device__ __forceinline__ void gla_scan_lds(Frame& F, int item) {
    const int tid = F.tid, lane = F.lane, w = F.wave, g = lane >> 4, r = lane & 15;
    const int bh = item >> 2, q4 = item & 3, b = bh >> 2, h = bh & 3;
    LAS unsigned char* bufA = F.lds + PH_OFF;
    LAS unsigned char* bufB = bufA + SCA_BYTES;
    const size_t ch0 = (size_t)bh * 32;
#define SCAN_LOAD_A(ch) do { const u32x4* q_ = (const u32x4*)(F_qf + (size_t)(ch) * 16384) + lt; const u32x4* a_ = (const u32x4*)(F_af + (size_t)(ch) * 4096) + lt; const u32x4* v_ = (const u32x4*)(F_vf + (size_t)(ch) * 32768 + q4 * 8192) + lt; \
        _Pragma("unroll") for (int j = 0; j < 8; ++j) ra[j] = q_[256 * j]; ra[8] = a_[0]; ra[9] = a_[256]; _Pragma("unroll") for (int j = 0; j < 4; ++j) ra[10 + j] = v_[256 * j]; } while (0)
#define SCAN_LOAD_B(ch) do { const u32x4* k_ = (const u32x4*)(F_kf + (size_t)(ch) * 16384) + lt; _Pragma("unroll") for (int j = 0; j < 8; ++j) rb[j] = k_[256 * j]; if (lt < 64) rb[8] = ((const u32x4*)(F_dl + (size_t)(ch) * 256))[lt]; } while (0)
#define SCAN_PUT_A() do { _Pragma("unroll") for (int j = 0; j < 14; ++j) *(LAS u32x4*)(bufA + (lt + 256 * j) * 16) = ra[j]; } while (0)
#define SCAN_PUT_B() do { _Pragma("unroll") for (int j = 0; j < 8; ++j) *(LAS u32x4*)(bufB + (lt + 256 * j) * 16) = rb[j]; if (lt < 64) *(LAS u32x4*)(bufB + (lt + 2048) * 16) = rb[8]; } while (0)
    if (w >= 4) {
        const int lt = tid - 256;
        u32x4 ra[14], rb[9];
        SCAN_LOAD_A(ch0); SCAN_LOAD_B(ch0); SCAN_PUT_A();
        SC_BAR();
#pragma unroll 1
        for (int n = 0; n < 32; ++n) {
            const size_t chn = ch0 + (n < 31 ? n + 1 : 31);
            SCAN_PUT_B(); SCAN_LOAD_A(chn);
            SC_BAR();
            SCAN_PUT_A(); SCAN_LOAD_B(chn);
            SC_BAR();
        }
    } else {
        f32x4 S[16][2];
#pragma unroll
        for (int i = 0; i < 16; ++i) { S[i][0] = (f32x4){0.f, 0.f, 0.f, 0.f}; S[i][1] = (f32x4){0.f, 0.f, 0.f, 0.f}; }
        SC_BAR();
#pragma unroll 1
        for (int n = 0; n < 32; ++n) {
            const LAS bf16x8* qfp = (const LAS bf16x8*)bufA + lane;
            const LAS bf16x8* afp = (const LAS bf16x8*)(bufA + 32768) + lane;
            const LAS bf16x8* vfp = (const LAS bf16x8*)(bufA + 40960) + (w * 4) * 64 + lane;
            const bf16x8 vb00 = vfp[0], vb01 = vfp[64], vb10 = vfp[128], vb11 = vfp[192];
            f32x4 o[4][2];
#pragma unroll
            for (int tt = 0; tt < 4; ++tt) { o[tt][0] = (f32x4){0.f, 0.f, 0.f, 0.f}; o[tt][1] = (f32x4){0.f, 0.f, 0.f, 0.f}; }
#pragma unroll
            for (int T = 0; T < 8; ++T) {
                bf16x8 sb[2];
#pragma unroll
                for (int d = 0; d < 2; ++d) { u32x4 sw; sw.x = pk2s(S[2 * T][d][0], S[2 * T][d][1]); sw.y = pk2s(S[2 * T][d][2], S[2 * T][d][3]); sw.z = pk2s(S[2 * T + 1][d][0], S[2 * T + 1][d][1]); sw.w = pk2s(S[2 * T + 1][d][2], S[2 * T + 1][d][3]); sb[d] = __builtin_bit_cast(bf16x8, sw); }
#pragma unroll
                for (int tt = 0; tt < 4; ++tt) { const bf16x8 a = qfp[(T * 4 + tt) * 64]; o[tt][0] = mfma16(sb[0], a, o[tt][0]); o[tt][1] = mfma16(sb[1], a, o[tt][1]); }
            }
#pragma unroll
            for (int tt = 0; tt < 4; ++tt) { const bf16x8 a0 = afp[(tt * 2 + 0) * 64], a1 = afp[(tt * 2 + 1) * 64];
                o[tt][0] = mfma16(vb00, a0, o[tt][0]); o[tt][0] = mfma16(vb01, a1, o[tt][0]); o[tt][1] = mfma16(vb10, a0, o[tt][1]); o[tt][1] = mfma16(vb11, a1, o[tt][1]); }
            bf16* op = F_obuf + (size_t)(b * SEQ + n * 64 + r) * 2048 + h * 512 + 128 * q4 + 32 * w + 4 * g;
#pragma unroll
            for (int tt = 0; tt < 4; ++tt)
#pragma unroll
                for (int d = 0; d < 2; ++d) { u32x2 ov; ov.x = pk2s(o[tt][d][0], o[tt][d][1]); ov.y = pk2s(o[tt][d][2], o[tt][d][3]); *(u32x2*)(op + (size_t)(16 * tt) * 2048 + 16 * d) = ov; }
            SC_BAR();
            const LAS bf16x8* kfp = (const LAS bf16x8*)bufB + lane;
            const LAS f32x4* dlp = (const LAS f32x4*)(bufB + 32768) + g;
#pragma unroll
            for (int dkt = 0; dkt < 16; ++dkt) { const f32x4 d4 = dlp[4 * dkt]; const bf16x8 k0 = kfp[(dkt * 2 + 0) * 64], k1 = kfp[(dkt * 2 + 1) * 64];
                S[dkt][0] = S[dkt][0] * d4; S[dkt][1] = S[dkt][1] * d4;
                S[dkt][0] = mfma16(k0, vb00, S[dkt][0]); S[dkt][0] = mfma16(k1, vb01, S[dkt][0]); S[dkt][1] = mfma16(k0, vb10, S[dkt][1]); S[dkt][1] = mfma16(k1, vb11, S[dkt][1]); }
            SC_BAR();
        }
    }
#undef SCAN_LOAD_A
#undef SCAN_LOAD_B
#undef SCAN_PUT_A
#undef SCAN_PUT_B
}

__device__ __forceinline__ void gla_norm_phase(Frame& F) {
    const int gw = blockIdx.x * NWAVES + F.wave, NGW = F.G * NWAVES, lane = F.lane;
    const f32x4 g0 = *(const f32x4*)(F_gla_g + lane * 8), g1 = *(const f32x4*)(F_gla_g + lane * 8 + 4);
    for (int tok = gw; tok < MTOK; tok += NGW) {
        u32x4 owv[4], gwv[4];
#pragma unroll
        for (int h = 0; h < 4; ++h) { owv[h] = *(const u32x4*)(F_obuf + (size_t)tok * 2048 + h * 512 + lane * 8); gwv[h] = *(const u32x4*)(F_proj + (size_t)tok * LDP + C_GOUT + h * 512 + lane * 8); }
#pragma unroll
        for (int h = 0; h < 4; ++h) { const u32x4 ow = owv[h], gw4 = gwv[h];
            const f32x4 a = {bflo(ow.x), bfhi(ow.x), bflo(ow.y), bfhi(ow.y)}, bq = {bflo(ow.z), bfhi(ow.z), bflo(ow.w), bfhi(ow.w)};
            const float ss = (a.x * a.x + a.y * a.y) + (a.z * a.z + a.w * a.w) + (bq.x * bq.x + bq.y * bq.y) + (bq.z * bq.z + bq.w * bq.w);
            const float rstd = rsqrtf(wave_sum(ss) * (1.f / 512.f) + EPS);
            float go[8] = {bflo(gw4.x), bfhi(gw4.x), bflo(gw4.y), bfhi(gw4.y), bflo(gw4.z), bfhi(gw4.z), bflo(gw4.w), bfhi(gw4.w)};
            float y[8] = {a.x * g0.x, a.y * g0.y, a.z * g0.z, a.w * g0.w, bq.x * g1.x, bq.y * g1.y, bq.z * g1.z, bq.w * g1.w};
#pragma unroll
            for (int e = 0; e < 8; ++e) y[e] = y[e] * rstd * (go[e] / (1.f + __expf(-go[e])));
            u32x4 o; o.x = pk2(y[0], y[1]); o.y = pk2(y[2], y[3]); o.z = pk2(y[4], y[5]); o.w = pk2(y[6], y[7]);
            *(u32x4*)(F_cat + (size_t)tok * LDK + 2048 + h * 512 + lane * 8) = o; }
    }
}

struct EpiResid {
    static constexpr bool PERM = false, AFTER_DRAIN = false;
    const float* x; const float* mod; bf16* x1;
    __device__ __forceinline__ void operator()(const pg8::f32x4 (&acc)[2][2][4][2], const pg8::Unit& u, int wr, int wc, int fr, int fq) const {
        const int row0 = u.pm * 256 + wr * 64 + fr, col0 = u.pn * 256 + wc * 32 + 4 * fq;
        const int b = (u.pm * 256) / SEQ;
        const float* gp = mod + (size_t)b * NMOD + 2 * DM + col0;
        pg8::f32x4 gv[2][2];
#pragma unroll
        for (int bj = 0; bj < 2; ++bj)
#pragma unroll
            for (int n = 0; n < 2; ++n) gv[bj][n] = *(const pg8::f32x4*)(gp + bj * 128 + n * 16);
#pragma unroll
        for (int ai = 0; ai < 2; ++ai)
#pragma unroll
            for (int m = 0; m < 4; ++m) { const size_t off = (size_t)(row0 + ai * 128 + m * 16) * DM + col0;
#pragma unroll
                for (int bj = 0; bj < 2; ++bj)
#pragma unroll
                    for (int n = 0; n < 2; ++n) { const pg8::f32x4 xv = *(const pg8::f32x4*)(x + off + bj * 128 + n * 16); const pg8::f32x4 y = xv + gv[bj][n] * acc[ai][bj][m][n];
                        u32x2 o; o.x = pk2(y.x, y.y); o.y = pk2(y.z, y.w); *(u32x2*)(x1 + off + bj * 128 + n * 16) = o; } }
    }
};

__device__ __forceinline__ float gelu_erf(float v) { return 0.5f * v * (1.f + erff(v * 0.70710678118654752f)); }
__device__ __forceinline__ void wave_argmax(float& bv, int& bi) {
#pragma unroll
    for (int o = 32; o >= 1; o >>= 1) { const float ov = __shfl_xor(bv, o); const int oi = __shfl_xor(bi, o); if (ov > bv || (ov == bv && oi < bi)) { bv = ov; bi = oi; } }
}
template <int CTRL> __device__ __forceinline__ float dpp_add(float v) { return v + __builtin_bit_cast(float, __builtin_amdgcn_update_dpp(0, __builtin_bit_cast(int, v), CTRL, 0xf, 0xf, true)); }
__device__ __forceinline__ unsigned mono_key(float v) { const unsigned b = __builtin_bit_cast(unsigned, v); return (b & 0x80000000u) ? ~b : (b | 0x80000000u); }
__device__ __forceinline__ float unmono(unsigned u) { const unsigned b = (u & 0x80000000u) ? (u ^ 0x80000000u) : ~u; return __builtin_bit_cast(float, b); }
template <int CTRL> __device__ __forceinline__ unsigned dpp_u(unsigned v) { return (unsigned)__builtin_amdgcn_update_dpp(0, (int)v, CTRL, 0xf, 0xf, true); }
__device__ __forceinline__ unsigned med3u(unsigned a, unsigned b, unsigned c) { unsigned r; asm("v_med3_u32 %0, %1, %2, %3" : "=v"(r) : "v"(a), "v"(b), "v"(c)); return r; }
#define INS16(top, val) do { const unsigned v_ = (val); unsigned n_[16]; n_[0] = top[0] > v_ ? top[0] : v_; \
    _Pragma("unroll") for (int j_ = 1; j_ < 16; ++j_) n_[j_] = med3u(top[j_ - 1], v_, top[j_]); \
    _Pragma("unroll") for (int j_ = 0; j_ < 16; ++j_) top[j_] = n_[j_]; } while (0)
struct EpiKeys {
    static constexpr bool PERM = false, AFTER_DRAIN = false;
    unsigned* SK;
    __device__ __forceinline__ void operator()(const pg8::f32x4 (&acc)[2][2][4][2], const pg8::Unit& u, int wr, int wc, int fr, int fq) const {
        const int row0 = u.pm * 256 + wr * 64 + fr, kc = wc * 32 + 4 * fq, col0 = u.pn * 256 + kc;
#pragma unroll
        for (int ai = 0; ai < 2; ++ai)
#pragma unroll
            for (int m = 0; m < 4; ++m) { unsigned* rowp = SK + (size_t)(row0 + ai * 128 + m * 16) * 2048 + col0;
#pragma unroll
                for (int bj = 0; bj < 2; ++bj)
#pragma unroll
                    for (int n = 0; n < 2; ++n) { const pg8::f32x4 v = acc[ai][bj][m][n]; const unsigned k0 = (unsigned)(127 - (kc + 16 * n));
                        u32x4 o; o.x = (mono_key(v[0]) & ~127u) | k0; o.y = (mono_key(v[1]) & ~127u) | (k0 - 1u); o.z = (mono_key(v[2]) & ~127u) | (k0 - 2u); o.w = (mono_key(v[3]) & ~127u) | (k0 - 3u);
                        *(u32x4*)(rowp + bj * 128 + n * 16) = o; } }
    }
};
constexpr int KS_LD = 130;
__device__ __forceinline__ void peer_select_lists(Frame& F, LAS unsigned* KS, LAS unsigned char* IL, int tok0, int hh) {
    const int tid = F.tid;
    __syncthreads();
    const int L = tid >> 1, half = tid & 1;
    unsigned top[16];
#pragma unroll
    for (int j = 0; j < 16; ++j) top[j] = 0u;
    {
        const LAS unsigned* kp = KS + L * KS_LD + half * 65;
#pragma unroll 4
        for (int i = 0; i < 64; ++i) INS16(top, kp[i]);
    }
    {
        unsigned oth[16];
#pragma unroll
        for (int j = 0; j < 16; ++j) oth[j] = dpp_u<0xB1>(top[j]);
#pragma unroll
        for (int j = 0; j < 16; ++j) INS16(top, oth[j]);
    }
    if (half == 0) {
#pragma unroll
        for (int j4 = 0; j4 < 4; ++j4) { unsigned pw = 0u;
#pragma unroll
            for (int j = 0; j < 4; ++j) pw |= (127u - (top[4 * j4 + j] & 127u)) << (8 * j);
            *(LAS unsigned*)(IL + L * 16 + 4 * j4) = pw; }
    }
    unsigned t2[16];
    {
        float f1[16], f2[16];
#pragma unroll
        for (int j = 0; j < 16; ++j) { const unsigned o = dpp_u<0x4E>(top[j]); const bool p1 = (tid & 2) != 0;
            f1[j] = unmono((p1 ? o : top[j]) & ~127u); f2[j] = unmono((p1 ? top[j] : o) & ~127u); }
#pragma unroll
        for (int j = 0; j < 16; ++j) t2[j] = 0u;
#pragma unroll
        for (int a = 0; a < 16; ++a)
#pragma unroll
            for (int b = 0; b < 16; ++b) if ((a + 1) * (b + 1) <= 16) { const float sm = f1[a] + f2[b]; INS16(t2, (mono_key(sm) & ~255u) | (unsigned)(255 - (a * 16 + b))); }
    }
    __syncthreads();
    if ((tid & 3) == 0) {
        const int th = tid >> 2, tl = th, h = hh, L0 = th * 2;
        float ex[16]; const float mx = unmono(t2[0] & ~255u); float den = 0.f;
#pragma unroll
        for (int j = 0; j < 16; ++j) { ex[j] = __expf(unmono(t2[j] & ~255u) - mx); den += ex[j]; }
        const float inv = 1.f / den;
        unsigned pw[8];
#pragma unroll
        for (int j = 0; j < 8; ++j) pw[j] = 0u;
#pragma unroll
        for (int j = 0; j < 16; ++j) { const unsigned cand = 255u - (t2[j] & 255u); const unsigned e = (unsigned)IL[L0 * 16 + (cand >> 4)] * 128u + (unsigned)IL[(L0 + 1) * 16 + (cand & 15u)];
            pw[j >> 1] |= e << (16 * (j & 1)); ex[j] *= inv; }
        const size_t o = (size_t)(tok0 + tl) * 128 + h * 16;
        *(u32x4*)(F_pidx + o) = (u32x4){pw[0], pw[1], pw[2], pw[3]}; *(u32x4*)(F_pidx + o + 8) = (u32x4){pw[4], pw[5], pw[6], pw[7]};
#pragma unroll
        for (int j4 = 0; j4 < 4; ++j4) *(f32x4*)(F_gate + o + 4 * j4) = (f32x4){ex[4 * j4], ex[4 * j4 + 1], ex[4 * j4 + 2], ex[4 * j4 + 3]};
    }
    __syncthreads();
}
__device__ __forceinline__ void peer_select_phase(Frame& F) {
    const int tid = F.tid;
    LAS unsigned* KS = (LAS unsigned*)(F.lds + PH_OFF);
    LAS unsigned char* IL = (LAS unsigned char*)(KS + 256 * KS_LD);
    pg8::StaticOrder S; S.init(MTOK, 2048, F.G, (int)blockIdx.x);
    for (int it2 = 0; ; ++it2) {
        pg8::Unit un; if (!S.next(it2 >> 1, un)) break;
        const int tok0 = un.pm * 256 + (it2 & 1) * 128, hh = un.pn;
        {
#pragma unroll 8
            for (int e = tid; e < 256 * 32; e += NTHR) { const int L = e >> 5, c4 = (e & 31) * 4;
                const u32x4 v = *(const u32x4*)(F_sk + (size_t)(tok0 + (L >> 1)) * 2048 + hh * 256 + (L & 1) * 128 + c4);
                LAS unsigned* d = KS + L * KS_LD + (c4 >> 6) * 65 + (c4 & 63); d[0] = v.x; d[1] = v.y; d[2] = v.z; d[3] = v.w; }
        }
        peer_select_lists(F, KS, IL, tok0, hh);
    }
}
struct EpiKeysFused {
    static constexpr bool PERM = false, AFTER_DRAIN = true;
    Frame* Fp;
    __device__ __forceinline__ void fused(const pg8::f32x4 (&acc)[2][2][4][2], const pg8::Unit& u, int wr, int wc, int fr, int fq, PG8_LAS unsigned char* lds, int wid, int lane) const {
        Frame& F = *Fp;
        LAS unsigned* KS = (LAS unsigned*)(F.lds + PH_OFF);
        LAS unsigned char* IL = (LAS unsigned char*)(KS + 256 * KS_LD);
#pragma unroll
        for (int ai = 0; ai < 2; ++ai) {
#pragma unroll
            for (int m = 0; m < 4; ++m) { const int tl = wr * 64 + 16 * m + fr;
#pragma unroll
                for (int bj = 0; bj < 2; ++bj)
#pragma unroll
                    for (int n = 0; n < 2; ++n) { const pg8::f32x4 v = acc[ai][bj][m][n]; const int key = wc * 32 + 16 * n + 4 * fq;
                        LAS unsigned* d = KS + (tl * 2 + bj) * KS_LD + (key >> 6) * 65 + (key & 63); const unsigned k0 = (unsigned)(127 - key);
                        d[0] = (mono_key(v[0]) & ~127u) | k0; d[1] = (mono_key(v[1]) & ~127u) | (k0 - 1u); d[2] = (mono_key(v[2]) & ~127u) | (k0 - 2u); d[3] = (mono_key(v[3]) & ~127u) | (k0 - 3u); } }
            peer_select_lists(F, KS, IL, u.pm * 256 + ai * 128, u.pn);
        }
    }
};
template <int NS, int TAPER, int FINE, class Body> __device__ __forceinline__ void peer_sliced_queue(Frame& F, unsigned* heads, Body body) {
#define PCHQ(s_) ((s_) >= TAPER ? FINE : 128)
    volatile LAS int* qw = (volatile LAS int*)(F.lds + MISC_OFF + 64);
    const unsigned x = xb_xcc_id() & 7u;
    unsigned long long done = 0ull;
    for (int pass = 0; pass < NS / 8 + 1; ++pass) {
        for (;;) {
            int s;
            if (pass < NS / 8) s = (int)((x + 8u * (unsigned)pass) & (unsigned)(NS - 1));
            else {
                if (F.wave == 0) { const unsigned v = F.lane < NS ? __hip_atomic_load(heads + 64 * F.lane, __ATOMIC_RELAXED, __HIP_MEMORY_SCOPE_AGENT) : 0xffffffffu;
                    const unsigned long long m = __ballot(v < (unsigned)(MTOK / PCHQ(F.lane & (NS - 1)))) & ~done; if (F.lane == 0) qw[1] = m ? (int)__builtin_ctzll(m) : -1; }
                __syncthreads(); s = qw[1]; __syncthreads();
                if (s < 0) break;
            }
            if (F.tid == 0) qw[0] = (int)__hip_atomic_fetch_add(heads + 64 * s, 1u, __ATOMIC_RELAXED, __HIP_MEMORY_SCOPE_AGENT);
            __syncthreads(); int c = qw[0]; __syncthreads();
            const int npch = MTOK / PCHQ(s);
            while (c < npch) {
                if (F.tid == 0) qw[0] = (int)__hip_atomic_fetch_add(heads + 64 * s, 1u, __ATOMIC_RELAXED, __HIP_MEMORY_SCOPE_AGENT);
                body(s, c);
                __syncthreads(); c = qw[0]; __syncthreads();
            }
            done |= 1ull << s;
            if (pass < NS / 8) break;
        }
    }
}
#undef PCHQ
typedef float f32x2v __attribute__((ext_vector_type(2)));
template <int CTRL> __device__ __forceinline__ int dpp_addi(int v) { return v + __builtin_amdgcn_update_dpp(0, v, CTRL, 0xf, 0xf, true); }
constexpr int NSLU = 16, UTAPER = 8, UFINE = 64;
__device__ __forceinline__ void peer_u_chunk(Frame& F, int s, int c) {
    const int lane = F.lane, p = lane >> 3, q = lane & 7;
    const unsigned char* ub = F_u8 + (size_t)s * ((size_t)NEXP * 128) + 16 * q;
    const int pch8 = (s >= UTAPER ? UFINE : 128) >> 3;
#pragma unroll 1
    for (int i = 0; i < pch8; ++i) {
        const int t = (c * 8 + F.wave) * pch8 + i;
        const u32x4 hH = *(const u32x4*)(F_h8 + (size_t)t * 2048 + 128 * s + 16 * q);
        const u32x4 hL = *(const u32x4*)(F_h8 + (size_t)MTOK * 2048 + (size_t)t * 2048 + 128 * s + 16 * q);
        const u32x4* ip = (const u32x4*)(F_pidx + (size_t)t * 128 + p * 16);
        const u32x4 i0 = ip[0], i1 = ip[1];
        const unsigned iw[8] = {i0.x, i0.y, i0.z, i0.w, i1.x, i1.y, i1.z, i1.w};
        u32x4 a[16];
#pragma unroll
        for (int st = 0; st < 16; ++st) { const unsigned id = (st & 1) ? (iw[st >> 1] >> 16) : (iw[st >> 1] & 0xffffu); a[st] = *(const u32x4*)(ub + (size_t)id * 128); }
        const int hh[4] = {(int)hH.x, (int)hH.y, (int)hH.z, (int)hH.w}, hl[4] = {(int)hL.x, (int)hL.y, (int)hL.z, (int)hL.w};
        int sh = 0, sl = 0;
#pragma unroll
        for (int d = 0; d < 4; ++d) { sh = __builtin_amdgcn_sdot8(hh[d], 0x11111111, sh, false); sl = __builtin_amdgcn_sdot8(hl[d], 0x11111111, sl, false); }
        const int cst = 16 * sh + sl;
        int dv[16];
#pragma unroll
        for (int st = 0; st < 16; ++st) {
            const int xw[4] = {(int)a[st].x, (int)a[st].y, (int)a[st].z, (int)a[st].w};
            int dh = 0, dl = 0;
#pragma unroll
            for (int dd = 0; dd < 4; ++dd) { dh = __builtin_amdgcn_sdot8(xw[dd], hh[dd], dh, false); dl = __builtin_amdgcn_sdot8(xw[dd], hl[dd], dl, false); }
            dv[st] = 32 * dh + 2 * dl + cst; }
        int v8[8], v4[4], v2[2];
        { const bool b0 = (q & 1) != 0;
#pragma unroll
          for (int j = 0; j < 8; ++j) { const int keep = b0 ? dv[j + 8] : dv[j], send = b0 ? dv[j] : dv[j + 8]; v8[j] = keep + __builtin_amdgcn_update_dpp(0, send, 0xB1, 0xf, 0xf, true); } }
        { const bool b1 = (q & 2) != 0;
#pragma unroll
          for (int j = 0; j < 4; ++j) { const int keep = b1 ? v8[j + 4] : v8[j], send = b1 ? v8[j] : v8[j + 4]; v4[j] = keep + __builtin_amdgcn_update_dpp(0, send, 0x4E, 0xf, 0xf, true); } }
        { const bool b2 = (q & 4) != 0;
#pragma unroll
          for (int j = 0; j < 2; ++j) { const int keep = b2 ? v4[j + 2] : v4[j], send = b2 ? v4[j] : v4[j + 2];
              int x = __builtin_amdgcn_update_dpp(0, send, 0x104, 0xf, 0x5, false);
              x = __builtin_amdgcn_update_dpp(x, send, 0x114, 0xf, 0xa, false);
              v2[j] = keep + x; } }
        const int st0 = 8 * (q & 1) + 4 * ((q >> 1) & 1) + 2 * (q >> 2);
        *(unsigned*)(F_part + ((size_t)s * MTOK + t) * 128 + p * 16 + st0) = pk2((float)v2[0], (float)v2[1]);
    }
}
__device__ __forceinline__ void peer_reduce_phase(Frame& F) {
    const size_t gt = (size_t)blockIdx.x * NTHR + F.tid, NT = (size_t)F.G * NTHR;
    for (size_t i = gt; i < (size_t)MTOK * 128 / 4; i += NT) {
        f32x4 a = {0.f, 0.f, 0.f, 0.f};
#pragma unroll 8
        for (int s = 0; s < NSLU; ++s) { const u32x2 pw = *(const u32x2*)(F_part + (size_t)s * MTOK * 128 + 4 * i); a += (f32x4){bflo(pw.x), bfhi(pw.x), bflo(pw.y), bfhi(pw.y)}; }
        const f32x4 gt4 = *(const f32x4*)(F_gate + 4 * i);
        const u32x2 id2 = *(const u32x2*)(F_pidx + 4 * i);
        const unsigned e0 = id2.x & 0xffffu, e1 = id2.x >> 16, e2 = id2.y & 0xffffu, e3 = id2.y >> 16;
        a = a * (0.5f * F_hinv[i >> 5]);
        f32x4 o; o.x = gt4.x * gelu_erf(a.x * F_isu[e0]) * F_isv[e0]; o.y = gt4.y * gelu_erf(a.y * F_isu[e1]) * F_isv[e1];
        o.z = gt4.z * gelu_erf(a.z * F_isu[e2]) * F_isv[e2]; o.w = gt4.w * gelu_erf(a.w * F_isu[e3]) * F_isv[e3];
        float wm = fmaxf(fmaxf(fabsf(o.x), fabsf(o.y)), fmaxf(fabsf(o.z), fabsf(o.w)));
#pragma unroll
        for (int sh = 1; sh < 32; sh <<= 1) wm = fmaxf(wm, __shfl_xor(wm, sh));
        const float sc = wm > 0.f ? 127.f / wm : 1.f;
        *(unsigned*)(F_wq + 4 * i) = q8x4(o * sc);
        if ((i & 31) == 0) F_wsc[i >> 5] = wm > 0.f ? wm * (1.f / 127.f) : 1.f;
    }
}
__device__ __forceinline__ void tr4x4(unsigned r0, unsigned r1, unsigned r2, unsigned r3, unsigned& c0, unsigned& c1, unsigned& c2, unsigned& c3) {
    const unsigned t01l = __builtin_amdgcn_perm(r1, r0, 0x05010400u), t01h = __builtin_amdgcn_perm(r1, r0, 0x07030602u);
    const unsigned t23l = __builtin_amdgcn_perm(r3, r2, 0x05010400u), t23h = __builtin_amdgcn_perm(r3, r2, 0x07030602u);
    c0 = __builtin_amdgcn_perm(t23l, t01l, 0x05040100u); c1 = __builtin_amdgcn_perm(t23l, t01l, 0x07060302u);
    c2 = __builtin_amdgcn_perm(t23h, t01h, 0x05040100u); c3 = __builtin_amdgcn_perm(t23h, t01h, 0x07060302u);
}
__device__ __forceinline__ void peer_v_chunk(Frame& F, int s, int c) {
    const int lane = F.lane, p = lane >> 3, q = lane & 7;
    const unsigned char* vb = F_v8 + (size_t)s * ((size_t)NEXP * SLW) + 16 * q;
    const int pch8 = pch_of(s) >> 3;
#pragma unroll 1
    for (int i = 0; i < pch8; ++i) {
        const int t = (c * 8 + F.wave) * pch8 + i;
        const u32x4* ip = (const u32x4*)(F_pidx + (size_t)t * 128 + p * 16);
        const u32x4 i0 = ip[0], i1 = ip[1];
        const unsigned iw[8] = {i0.x, i0.y, i0.z, i0.w, i1.x, i1.y, i1.z, i1.w};
        const u32x4 wq4 = *(const u32x4*)(F_wq + (size_t)t * 128 + p * 16);
        const unsigned wqm[4] = {wq4.x, wq4.y, wq4.z, wq4.w};
        u32x4 a[16];
#pragma unroll
        for (int st = 0; st < 16; ++st) { const unsigned id = (st & 1) ? (iw[st >> 1] >> 16) : (iw[st >> 1] & 0xffffu); a[st] = *(const u32x4*)(vb + (size_t)id * SLW); }
        int acc[16];
#pragma unroll
        for (int j = 0; j < 16; ++j) acc[j] = 0;
#pragma unroll
        for (int m = 0; m < 4; ++m) {
            const unsigned r0[4] = {a[4 * m].x, a[4 * m].y, a[4 * m].z, a[4 * m].w}, r1[4] = {a[4 * m + 1].x, a[4 * m + 1].y, a[4 * m + 1].z, a[4 * m + 1].w};
            const unsigned r2[4] = {a[4 * m + 2].x, a[4 * m + 2].y, a[4 * m + 2].z, a[4 * m + 2].w}, r3[4] = {a[4 * m + 3].x, a[4 * m + 3].y, a[4 * m + 3].z, a[4 * m + 3].w};
#pragma unroll
            for (int wd = 0; wd < 4; ++wd) { unsigned c0, c1, c2, c3; tr4x4(r0[wd], r1[wd], r2[wd], r3[wd], c0, c1, c2, c3);
                acc[4 * wd] = __builtin_amdgcn_sdot4((int)c0, (int)wqm[m], acc[4 * wd], false); acc[4 * wd + 1] = __builtin_amdgcn_sdot4((int)c1, (int)wqm[m], acc[4 * wd + 1], false);
                acc[4 * wd + 2] = __builtin_amdgcn_sdot4((int)c2, (int)wqm[m], acc[4 * wd + 2], false); acc[4 * wd + 3] = __builtin_amdgcn_sdot4((int)c3, (int)wqm[m], acc[4 * wd + 3], false); }
        }
        int s8[8], s4[4], s2[2];
#pragma unroll
        for (int j = 0; j < 8; ++j) { const auto r = __builtin_amdgcn_permlane32_swap((unsigned)acc[j], (unsigned)acc[j + 8], false, false); s8[j] = (int)r[0] + (int)r[1]; }
#pragma unroll
        for (int j = 0; j < 4; ++j) { const auto r = __builtin_amdgcn_permlane16_swap((unsigned)s8[j], (unsigned)s8[j + 4], false, false); s4[j] = (int)r[0] + (int)r[1]; }
        const bool hi8 = (lane & 8) != 0;
#pragma unroll
        for (int j = 0; j < 2; ++j) { const int keep = hi8 ? s4[j + 2] : s4[j], send = hi8 ? s4[j] : s4[j + 2]; s2[j] = keep + __builtin_amdgcn_update_dpp(0, send, 0x128, 0xf, 0xf, true); }
        { const float ws = F_wsc[t]; *(unsigned*)(F_po + (size_t)t * DM + SLW * s + 16 * q + 2 * p) = pk2((float)s2[0] * ws, (float)s2[1] * ws); }
    }
}
__device__ __forceinline__ void final_phase(Frame& F) {
    const int gw = blockIdx.x * NWAVES + F.wave, NGW = F.G * NWAVES, lane = F.lane;
    for (int row = gw; row < MTOK; row += NGW) {
        const int b = row / SEQ;
        const float* g2p = F_mod + (size_t)b * NMOD + 5 * DM;
        const u32x2* xr = (const u32x2*)(F_x1 + (size_t)row * DM) + lane;
        const u32x2* pr = (const u32x2*)(F_po + (size_t)row * DM) + lane;
        f32x4 v[16]; float ss = 0.f;
#pragma unroll
        for (int j = 0; j < 16; ++j) { const int col = (lane + 64 * j) * 4; const u32x2 xw = xr[64 * j]; const f32x4 xv = {bflo(xw.x), bfhi(xw.x), bflo(xw.y), bfhi(xw.y)}, gv = *(const f32x4*)(g2p + col); const u32x2 pw = pr[64 * j];
            v[j].x = xv.x + gv.x * bflo(pw.x); v[j].y = xv.y + gv.y * bfhi(pw.x); v[j].z = xv.z + gv.z * bflo(pw.y); v[j].w = xv.w + gv.w * bfhi(pw.y);
            ss += (v[j].x * v[j].x + v[j].y * v[j].y) + (v[j].z * v[j].z + v[j].w * v[j].w); }
        const float rstd = rsqrtf(wave_sum(ss) * (1.f / DM) + EPS);
        f32x4* op = (f32x4*)(F_out + (size_t)row * DM) + lane;
#pragma unroll
        for (int j = 0; j < 16; ++j) { const int col = (lane + 64 * j) * 4; op[64 * j] = v[j] * rstd * *(const f32x4*)(F_final_g + col); }
    }
}

__global__ void __launch_bounds__(NTHR, 2) hybrid_fwd(Args args) {
    extern __shared__ __attribute__((aligned(16))) unsigned char lds_raw[];
    Frame F;
    F.lds = (LAS unsigned char*)lds_raw;
    F.tid = threadIdx.x; F.lane = F.tid & 63; F.wave = __builtin_amdgcn_readfirstlane(F.tid >> 6); F.G = gridDim.x;
    F.in = args.in; F.out = args.out; F.ws = args.ws;
    unsigned char* ws = args.ws;
    volatile LAS unsigned* MISC = (volatile LAS unsigned*)(F.lds + MISC_OFF);
    if (F.tid < 64) MISC[F.tid] = 0u;
    __syncthreads();
    unsigned* ctl = (unsigned*)(ws + WS_CTL);
    XcdBarrier bar; bar.bar = ctl + CW_BAR + args.li * XCD_BAR_WORDS; bar.x = 0; bar.st = nullptr;
    if (MK_N_LAUNCHES != NPHASE) bar = xcd_barrier_post(ctl + CW_BAR + args.li * XCD_BAR_WORDS, MISC + 8);
    const int lo = args.ph_lo, hi = args.ph_hi;
#ifndef PH_MASK
#define PH_MASK 0x3fff
#endif
#define IN(k) (((PH_MASK >> (k)) & 1) && lo <= (k) && (k) < hi)
#define SEAM(k) do { if (IN(k) && IN((k) + 1)) xcd_barrier(bar); LAUNDER_IDS(F); } while (0)
#ifndef REP_MASK
#define REP_MASK 0
#endif
#define NREP(k) ((((REP_MASK) >> (k)) & 1) ? 2 : 1)
    LAS unsigned char* gl = F.lds + PH_OFF;

    if (IN(0)) { _Pragma("unroll") for (int rep = 0; rep < NREP(0); ++rep) { if (rep) xcd_barrier(bar); p0_prologue(F); } }
    SEAM(0);
    if (IN(1)) { _Pragma("unroll") for (int rep = 0; rep < NREP(1); ++rep) { if (rep) xcd_barrier(bar); norm_mod_phase<false, false>(F, F_x, F_norm1_g, 0 * DM, 1 * DM, F_hb); } }
    SEAM(1);
    if (IN(2)) { _Pragma("unroll") for (int rep = 0; rep < NREP(2); ++rep) { if (rep) xcd_barrier(bar);
        pg8::Gemm gm{F_hb, F_win_t, MTOK, LDP, DM, LDK}; pg8::StaticOrder S; S.init(MTOK, LDP, F.G, (int)blockIdx.x);
        pg8::EpiBf16<0> E{F_proj, LDP, nullptr, 0, 0};
        pg8::gemm_phase<pg8::EpiBf16<0>, pg8::StaticOrder, false>(gl, gm, S, E, nullptr);
        __syncthreads();
        const int c2 = (int)((blockIdx.x + F.G - 96u) % (unsigned)F.G);
        { pg8::Gemm gv{F_win_t + (size_t)C_AV * LDK, F_hb, 256, MTOK, DM, LDK}; pg8::StaticOrder S2; S2.init(256, MTOK, F.G, c2);
          pg8::EpiBf16<0> E2{F_vt, MTOK, nullptr, 0, 0};
          pg8::gemm_phase<pg8::EpiBf16<0>, pg8::StaticOrder, false>(gl, gv, S2, E2, nullptr); }
        { pg8::Unit u5; if (!S.next(4, u5) && c2 >= 32) cvt_pull(F, ctl + CW_CVT, P2_CVT_BATCHES); } }
    }
    SEAM(2);
    if (IN(3)) { _Pragma("unroll") for (int rep = 0; rep < NREP(3); ++rep) { if (rep) xcd_barrier(bar);
        for (int it = blockIdx.x; it < 512; it += F.G) gla_prep_item(F, it);
        }
    }
    SEAM(3);
    if (IN(4)) { _Pragma("unroll") for (int rep = 0; rep < NREP(4); ++rep) { if (rep) xcd_barrier(bar); if (F.G > 64) { if (blockIdx.x < 64) { gla_scan_lds(F, (int)blockIdx.x); __syncthreads(); LAUNDER_IDS(F); trans_pull(F, (LAS float*)(F.lds + PH_OFF + F.wave * 8448)); cvt_pull(F, ctl + CW_CVT, 1 << 20); } else { LAUNDER_IDS(F); p4_side(F, (int)blockIdx.x - 64, F.G - 64); } }
        else { for (int it = blockIdx.x; it < 64; it += F.G) gla_scan_lds(F, it); __syncthreads(); p4_side(F, (int)blockIdx.x, F.G); } } }
    SEAM(4);
    if (IN(5)) { _Pragma("unroll") for (int rep = 0; rep < NREP(5); ++rep) { if (rep) xcd_barrier(bar); gla_norm_phase(F); } }
    SEAM(5);
    if (IN(6)) { _Pragma("unroll") for (int rep = 0; rep < NREP(6); ++rep) { if (rep) xcd_barrier(bar);
        pg8::Gemm gm{F_cat, F_wout_t, MTOK, DM, DM, LDK}; pg8::StaticOrder S; S.init(MTOK, DM, F.G, (int)blockIdx.x);
        EpiResid E{F_x, F_mod, F_x1};
        pg8::gemm_phase<EpiResid, pg8::StaticOrder, false>(gl, gm, S, E, nullptr); }
    }
    SEAM(6);
    if (IN(7)) { _Pragma("unroll") for (int rep = 0; rep < NREP(7); ++rep) { if (rep) xcd_barrier(bar); norm_mod_phase<true, true>(F, F_x1, F_norm2_g, 3 * DM, 4 * DM, F_hb); } }
    SEAM(7);
    if (IN(8)) { _Pragma("unroll") for (int rep = 0; rep < NREP(8); ++rep) { if (rep) xcd_barrier(bar);
        pg8::Gemm gm{F_hb, F_wq_t, MTOK, 2048, DM, LDK}; pg8::StaticOrder S; S.init(MTOK, 2048, F.G, (int)blockIdx.x);
        if (F.G == 256 && IN(9)) { EpiKeysFused E{&F}; pg8::gemm_phase<EpiKeysFused, pg8::StaticOrder, false>(gl, gm, S, E, nullptr); }
        else { EpiKeys E{F_sk}; pg8::gemm_phase<EpiKeys, pg8::StaticOrder, false>(gl, gm, S, E, nullptr); } }
    }
    if (IN(8) && IN(9)) { asm volatile("s_waitcnt vmcnt(0)" ::: "memory"); __syncthreads(); }
    LAUNDER_IDS(F);
    if (IN(9) && !(F.G == 256 && IN(8))) { _Pragma("unroll") for (int rep = 0; rep < NREP(9); ++rep) { if (rep) xcd_barrier(bar); peer_select_phase(F); } }
    SEAM(9);
    if (IN(10)) { _Pragma("unroll") for (int rep = 0; rep < NREP(10); ++rep) { if (rep) xcd_barrier(bar); peer_sliced_queue<NSLU, UTAPER, UFINE>(F, ctl + CW_QU + rep * 8192, [&](int s_, int c_) { peer_u_chunk(F, s_, c_); }); } }
    SEAM(10);
    if (IN(11)) { _Pragma("unroll") for (int rep = 0; rep < NREP(11); ++rep) { if (rep) xcd_barrier(bar); peer_reduce_phase(F); } }
    SEAM(11);
    if (IN(12)) { _Pragma("unroll") for (int rep = 0; rep < NREP(12); ++rep) { if (rep) xcd_barrier(bar); peer_sliced_queue<NSL, 24, 64>(F, ctl + CW_QV + rep * 8192, [&](int s_, int c_) { peer_v_chunk(F, s_, c_); }); } }
    SEAM(12);
    if (IN(13)) { _Pragma("unroll") for (int rep = 0; rep < NREP(13); ++rep) { if (rep) xcd_barrier(bar); final_phase(F); } }
#undef IN
#undef SEAM
}

extern "C" void kernel_launch(void* const* d_in, const int* in_sizes, int n_in, void* d_out, int out_size, void* d_ws, size_t ws_size, hipStream_t stream) {
    static int grid = 0;
    if (grid == 0) {
        if (n_in != 18 || out_size != MTOK * DM || ws_size < WS_END) { fprintf(stderr, "kernel_launch: unexpected shapes (n_in %d, out %d, ws %zu); nothing launched\n", n_in, out_size, ws_size); grid = -1; return; }
        int dev = 0, cus = 0, per_cu = 0;
        if (hipGetDevice(&dev) != hipSuccess || hipDeviceGetAttribute(&cus, hipDeviceAttributeMultiprocessorCount, dev) != hipSuccess) { grid = -1; return; }
        if (hipFuncSetAttribute((const void*)hybrid_fwd, hipFuncAttributeMaxDynamicSharedMemorySize, LDS_BYTES) != hipSuccess) { fprintf(stderr, "kernel_launch: hipFuncSetAttribute failed\n"); grid = -1; return; }
        if (hipOccupancyMaxActiveBlocksPerMultiprocessor(&per_cu, (const void*)hybrid_fwd, NTHR, LDS_BYTES) != hipSuccess || per_cu < 1) { fprintf(stderr, "kernel_launch: occupancy query says %d workgroups per CU\n", per_cu); }
        (void)hipGetLastError();
        grid = cus;
    }
    if (grid < 0) return;
    if (hipMemsetAsync((char*)d_ws + WS_CTL, 0, CTL_ZERO_BYTES, stream) != hipSuccess) { fprintf(stderr, "kernel_launch: memset failed\n"); return; }
    Args a{};
    for (int i = 0; i < 18; ++i) a.in[i] = (const float*)d_in[i];
    a.out = (float*)d_out; a.ws = (unsigned char*)d_ws;
    for (int li = 0; li < MK_N_LAUNCHES; ++li) {
        if (MK_N_LAUNCHES == NPHASE) { a.ph_lo = li; a.ph_hi = li + 1; } else { a.ph_lo = 0; a.ph_hi = NPHASE; }
        a.li = (MK_N_LAUNCHES == NPHASE) ? 0 : li;
        hipLaunchKernelGGL(hybrid_fwd, dim3(grid), dim3(NTHR), LDS_BYTES, stream, a);
        const hipError_t le = hipPeekAtLastError();
        if (le != hipSuccess) { fprintf(stderr, "kernel_launch: launch %d failed: %s\n", li, hipGetErrorName(le)); break; }
    }
}
```
